# Optimizing an MI355X kernel written in HIP

```python
import math
import jax, jax.numpy as jnp
from jax import lax
import numpy as np

D_MODEL = 1024
BATCH = 16
SEQ = 2048
DEPTH = 2

CHUNK = 64
D_MIX = D_MODEL
N_MIXERS = 4
GROUP_W = D_MIX // N_MIXERS
POOL_CH = GROUP_W
POOL_WINDOWS = (2, 4, 8, 16)
POOL_GROUPS = len(POOL_WINDOWS)
POOL_GROUP_CH = POOL_CH // POOL_GROUPS
SGU_CH = GROUP_W
SGU_HEADS = 4
SGU_HEAD_CH = SGU_CH // SGU_HEADS
SGU_BLOCK = 128
SCONV_CH = GROUP_W
SCONV_WIDTH = 3
SSD_INNER = GROUP_W
SSD_HEADDIM = 64
SSD_HEADS = SSD_INNER // SSD_HEADDIM
SSD_GROUPS = 2
SSD_STATE = 128
SSD_CONV = 4
SSD_CHUNK = CHUNK
SSD_BC = SSD_GROUPS * SSD_STATE
SSD_CONV_CH = SSD_INNER + 2 * SSD_BC
IN_COLS = POOL_CH + 2 * SGU_CH + 3 * SCONV_CH + 2 * SSD_INNER + 2 * SSD_BC + SSD_HEADS
D_FF = ((8 * D_MODEL + 3 * 256 - 1) // (3 * 256)) * 256
EPS = 1e-6

kernel_name = 'hybrid_parallel_head_group_streaming_encoder'


def _rmsnorm(x, g):
    xf = x.astype(jnp.float32)
    y = xf * lax.rsqrt(jnp.mean(jnp.square(xf), axis=-1, keepdims=True) + EPS)
    return (y * g.astype(jnp.float32)).astype(x.dtype)


def _split_columns(proj):
    sizes = [POOL_CH, SGU_CH, SGU_CH, SCONV_CH, SCONV_CH, SCONV_CH,
             SSD_INNER, SSD_INNER, SSD_BC, SSD_BC, SSD_HEADS]
    idx = [int(v) for v in np.cumsum(sizes)[:-1]]
    return jnp.split(proj, idx, axis=-1)


def _causal_dwconv(x, w):
    k_taps = w.shape[0]
    s = x.shape[1]
    xp = jnp.pad(x, ((0, 0), (k_taps - 1, 0), (0, 0)))
    out = xp[:, 0:s] * w[0]
    for k in range(1, k_taps):
        out = out + xp[:, k:k + s] * w[k]
    return out


def _pool_mixer(xp, w, bias, scale):
    b, s, _ = xp.shape
    xg = xp.reshape(b, s, POOL_GROUPS, POOL_GROUP_CH)
    xf = xg.astype(jnp.float32)
    cs = jnp.cumsum(xf, axis=1)
    pos = jnp.arange(s, dtype=jnp.float32)
    means = []
    for g, win in enumerate(POOL_WINDOWS):
        c = cs[:, :, g]
        lagged = jnp.pad(c, ((0, 0), (win, 0), (0, 0)))[:, :s]
        count = jnp.minimum(pos + 1.0, float(win))[:, None]
        means.append((c - lagged) / count)
    pooled = (jnp.stack(means, axis=2) - xf).astype(xp.dtype)
    y = jnp.einsum('bsgc,gcd->bsgd', pooled, w).reshape(b, s, POOL_CH) + bias
    return y * scale


def _spatial_gating(u, v, ln_g, ln_b, w_s, b_s):
    b, s, _ = v.shape
    vf = v.astype(jnp.float32)
    mu = jnp.mean(vf, axis=-1, keepdims=True)
    var = jnp.mean(jnp.square(vf - mu), axis=-1, keepdims=True)
    vn = ((vf - mu) * lax.rsqrt(var + EPS)).astype(v.dtype) * ln_g + ln_b
    nb = s // SGU_BLOCK
    vb = vn.reshape(b, nb, SGU_BLOCK, SGU_HEADS, SGU_HEAD_CH)
    chunk_id = jnp.arange(SGU_BLOCK) // CHUNK
    mask = chunk_id[:, None] >= chunk_id[None, :]
    w = jnp.where(mask[None], w_s, jnp.zeros_like(w_s))
    mixed = jnp.einsum('hij,bnjhc->bnihc', w, vb) + b_s.T[None, None, :, :, None]
    return u * mixed.reshape(b, s, SGU_CH)


def _short_conv_mixer(bg, cg, h, w):
    return bg * _causal_dwconv(cg * h, w)


def _ssd_mixer(z, xs, bm, cm, dt, conv_w, conv_b, dt_bias, a_log, d_skip, norm_g):
    dtype = z.dtype
    f32 = jnp.float32
    b, s, _ = xs.shape
    nc = s // SSD_CHUNK
    xbc = jax.nn.silu(_causal_dwconv(jnp.concatenate([xs, bm, cm], axis=-1), conv_w) + conv_b).astype(f32)
    xh = xbc[..., :SSD_INNER].reshape(b, nc, SSD_CHUNK, SSD_HEADS, SSD_HEADDIM)
    rep = SSD_HEADS // SSD_GROUPS
    bh = jnp.repeat(xbc[..., SSD_INNER:SSD_INNER + SSD_BC].reshape(b, nc, SSD_CHUNK, SSD_GROUPS, SSD_STATE), rep, axis=3)
    ch = jnp.repeat(xbc[..., SSD_INNER + SSD_BC:].reshape(b, nc, SSD_CHUNK, SSD_GROUPS, SSD_STATE), rep, axis=3)
    delta = jax.nn.softplus(dt.astype(f32) + dt_bias.astype(f32))
    a = -jnp.exp(a_log.astype(f32))
    delta_c = delta.reshape(b, nc, SSD_CHUNK, SSD_HEADS)
    a_cs = jnp.cumsum((delta_c * a).transpose(0, 3, 1, 2), axis=-1)
    x_dt = xh * delta_c[..., None]
    causal = jnp.tril(jnp.ones((SSD_CHUNK, SSD_CHUNK), dtype=bool))
    seg = a_cs[..., :, None] - a_cs[..., None, :]
    decay = jnp.exp(jnp.where(causal, seg, -jnp.inf))
    scores = jnp.einsum('bclhn,bcshn->bhcls', ch, bh) * decay
    y_diag = jnp.einsum('bhcls,bcshp->bclhp', scores, x_dt)
    to_end = jnp.exp(a_cs[..., -1:] - a_cs)
    states = jnp.einsum('bclhn,bhcl,bclhp->bchpn', bh, to_end, x_dt)
    chunk_decay = jnp.exp(a_cs[..., -1])

    def step(carry, inp):
        st, dec = inp
        return carry * dec[..., None, None] + st, carry

    init = jnp.zeros((b, SSD_HEADS, SSD_HEADDIM, SSD_STATE), f32)
    _, prev = lax.scan(step, init, (states.transpose(1, 0, 2, 3, 4), chunk_decay.transpose(2, 0, 1)))
    prev = prev.transpose(1, 0, 2, 3, 4)
    y_off = jnp.einsum('bclhn,bchpn,bhcl->bclhp', ch, prev, jnp.exp(a_cs))
    y = y_diag + y_off + xh * d_skip.astype(f32)[:, None]
    y = y.reshape(b, s, SSD_INNER) * jax.nn.silu(z.astype(f32))
    yg = y.reshape(b, s, SSD_GROUPS, SSD_INNER // SSD_GROUPS)
    yg = yg * lax.rsqrt(jnp.mean(jnp.square(yg), axis=-1, keepdims=True) + EPS)
    return (yg.reshape(b, s, SSD_INNER) * norm_g.astype(f32)).astype(dtype)


def setup_inputs(seed: int = 0) -> dict:
    key = jax.random.key(seed)
    ks = jax.random.split(key, 24)

    def nrm(k, shape, scale):
        return jax.random.normal(k, shape, jnp.float32) * scale

    L = DEPTH
    u = jax.random.uniform(ks[14], (L, SSD_HEADS), jnp.float32)
    dt0 = jnp.exp(u * (math.log(0.1) - math.log(1e-3)) + math.log(1e-3))
    dt_bias = dt0 + jnp.log(-jnp.expm1(-dt0))
    a_init = jax.random.uniform(ks[15], (L, SSD_HEADS), jnp.float32, 1.0, 16.0)
    return {
        'x': nrm(ks[0], (BATCH, SEQ, D_MODEL), 1.0),
        'norm_mix_g': 1.0 + nrm(ks[1], (L, D_MODEL), 0.02),
        'w_in': nrm(ks[2], (L, D_MODEL, IN_COLS), D_MODEL ** -0.5),
        'pool_w': nrm(ks[3], (L, POOL_GROUPS, POOL_GROUP_CH, POOL_GROUP_CH), POOL_GROUP_CH ** -0.5),
        'pool_b': nrm(ks[4], (L, POOL_CH), 0.02),
        'pool_scale': 1.0 + nrm(ks[5], (L, POOL_CH), 0.1),
        'sgu_ln_g': 1.0 + nrm(ks[6], (L, SGU_CH), 0.02),
        'sgu_ln_b': nrm(ks[7], (L, SGU_CH), 0.02),
        'sgu_w': nrm(ks[8], (L, SGU_HEADS, SGU_BLOCK, SGU_BLOCK), SGU_BLOCK ** -0.5),
        'sgu_b': 1.0 + nrm(ks[9], (L, SGU_HEADS, SGU_BLOCK), 0.1),
        'sconv_w': nrm(ks[10], (L, SCONV_WIDTH, SCONV_CH), SCONV_WIDTH ** -0.5),
        'ssd_conv_w': nrm(ks[11], (L, SSD_CONV, SSD_CONV_CH), SSD_CONV ** -0.5),
        'ssd_conv_b': nrm(ks[12], (L, SSD_CONV_CH), 0.02),
        'ssd_dt_bias': dt_bias,
        'ssd_a_log': jnp.log(a_init),
        'ssd_d': 1.0 + nrm(ks[13], (L, SSD_HEADS), 0.1),
        'ssd_norm_g': 1.0 + nrm(ks[16], (L, SSD_INNER), 0.02),
        'w_out': nrm(ks[17], (L, D_MIX, D_MODEL), D_MIX ** -0.5),
        'norm_ffn_g': 1.0 + nrm(ks[18], (L, D_MODEL), 0.02),
        'w_gate': nrm(ks[19], (L, D_MODEL, D_FF), D_MODEL ** -0.5),
        'w_up': nrm(ks[20], (L, D_MODEL, D_FF), D_MODEL ** -0.5),
        'w_down': nrm(ks[21], (L, D_FF, D_MODEL), D_FF ** -0.5),
        'final_norm_g': 1.0 + nrm(ks[22], (D_MODEL,), 0.02),
    }


def reference(x, norm_mix_g, w_in, pool_w, pool_b, pool_scale, sgu_ln_g, sgu_ln_b, sgu_w, sgu_b,
              sconv_w, ssd_conv_w, ssd_conv_b, ssd_dt_bias, ssd_a_log, ssd_d, ssd_norm_g,
              w_out, norm_ffn_g, w_gate, w_up, w_down, final_norm_g):
    h = x
    for l in range(DEPTH):
        hn = _rmsnorm(h, norm_mix_g[l])
        proj = jnp.einsum('bsd,de->bse', hn, w_in[l])
        (p_pool, p_u, p_v, p_cb, p_cc, p_ch,
         p_z, p_x, p_b, p_c, p_dt) = _split_columns(proj)
        y_a = _pool_mixer(p_pool, pool_w[l], pool_b[l], pool_scale[l])
        y_b = _spatial_gating(p_u, p_v, sgu_ln_g[l], sgu_ln_b[l], sgu_w[l], sgu_b[l])
        y_c = _short_conv_mixer(p_cb, p_cc, p_ch, sconv_w[l])
        y_d = _ssd_mixer(p_z, p_x, p_b, p_c, p_dt, ssd_conv_w[l], ssd_conv_b[l],
                         ssd_dt_bias[l], ssd_a_log[l], ssd_d[l], ssd_norm_g[l])
        mix = jnp.concatenate([y_a, y_b, y_c, y_d], axis=-1)
        h = h + jnp.einsum('bse,ed->bsd', mix, w_out[l])
        hn = _rmsnorm(h, norm_ffn_g[l])
        gate = jax.nn.silu(jnp.einsum('bsd,df->bsf', hn, w_gate[l]))
        up = jnp.einsum('bsd,df->bsf', hn, w_up[l])
        h = h + jnp.einsum('bsf,fd->bsd', gate * up, w_down[l])
    return _rmsnorm(h, final_norm_g)
```

```cpp
#include <hip/hip_runtime.h>
#include <cstdio>
#include <cstdint>
namespace pg8 {
#define PG8_LAS __attribute__((address_space(3)))
typedef unsigned short bf16_t;
typedef short bf16x8 __attribute__((ext_vector_type(8)));
typedef float f32x4 __attribute__((ext_vector_type(4)));
typedef unsigned u32x4 __attribute__((ext_vector_type(4)));
constexpr int BM = 256, BK = 64, HALF = 128, HTB = HALF * BK * 2  , STAGE_BYTES = 8 * HTB, NXCD = 8, WGM = 8;

__host__ __device__ __forceinline__ int lds_byte(int r, int c) { const int st = (r >> 4) * 2 + (c >> 5), rr = r & 15, cc = c & 31, ob = rr * 64 + cc * 2; return st * 1024 + (ob ^ (((ob >> 9) & 1) << 5)); }
__host__ __device__ __forceinline__ void stage_rc(int b, int& R, int& C) { const int st = b / 1024, sb = b % 1024, swz = sb ^ (((sb >> 9) & 1) << 5); R = (st >> 1) * 16 + swz / 64; C = (st & 1) * 32 + (swz % 64) / 2; }
__host__ __device__ __forceinline__ int perm32(int rho) { const int n = rho >> 4, i = rho & 15; return 8 * (i >> 2) + 4 * n + (i & 3); }

struct Unit { int pm, pn; };
struct Gemm { const bf16_t* A; const bf16_t* Bt; int M, N, K, pad; };

struct StaticOrder {
    int nM, nN, nwg, G, c;
    __host__ __device__ void init(int M, int N, int G_, int c_) { nM = M / BM; nN = N / BM; nwg = nM * nN; G = G_; c = c_; }
    __host__ __device__ bool next(int i, Unit& u) const {
        const long L = (long)i * G + c; if (L >= nwg) return false;
        int wgid = (int)L; { const int q = nwg / NXCD, r = nwg % NXCD, xcd = wgid % NXCD, off = wgid / NXCD; wgid = (xcd < r ? xcd * (q + 1) : r * (q + 1) + (xcd - r) * q) + off; }
        const int nig = WGM * nN, gid = wgid / nig, fm = gid * WGM, gsz = (nM - fm) < WGM ? (nM - fm) : WGM;
        u.pm = fm + ((wgid % nig) % gsz); u.pn = (wgid % nig) / gsz; return true;
    }
    __device__ __forceinline__ void a_ready(const Unit&) const {}
    __device__ __forceinline__ void done(const Unit&) const {}
};

__device__ __forceinline__ unsigned cvt_pk_bf16(float lo, float hi) { unsigned r; asm volatile("v_cvt_pk_bf16_f32 %0, %1, %2" : "=v"(r) : "v"(lo), "v"(hi)); return r; }
typedef float f32x2 __attribute__((ext_vector_type(2)));
__device__ __forceinline__ f32x2 gelu_pk(f32x2 v) {
    const f32x2 av = __builtin_elementwise_abs(v), d = av * 0.2316418882f + 1.0f;
    f32x2 t; t.x = __builtin_amdgcn_rcpf(d.x); t.y = __builtin_amdgcn_rcpf(d.y);
    f32x2 q = t * 0.5307027145f + (-0.7265760135f); q = q * t + 0.7107068705f; q = q * t + (-0.142248368f); q = q * t + 0.127414796f; q = q * t;
    const f32x2 s = (v * v) * (-0.72134752044f);
    f32x2 e; e.x = __builtin_amdgcn_exp2f(s.x); e.y = __builtin_amdgcn_exp2f(s.y);
    const f32x2 m = v * (q * e), r = v - m;
    f32x2 o; o.x = v.x < 0.f ? m.x : r.x; o.y = v.y < 0.f ? m.y : r.y; return o;
}

template <int ACT  > struct EpiBf16 {
    static constexpr bool PERM = true, AFTER_DRAIN = false; static_assert(ACT == 0 || ACT == 1, "EpiBf16: ACT is 0 (none) or 1 (gelu_pk)");
    bf16_t* O; const float* bias; size_t split_stride; int ldc; int split_cols; float scale0; int pad;
    __device__ __forceinline__ void operator()(const f32x4 (&acc)[2][2][4][2], const Unit& u, int wr, int wc, int fr, int fq) const {
        const int row0 = u.pm * BM + wr * 64 + fr; int colt = u.pn * BM; bf16_t* base = O;
        float sc = 1.f; if (split_cols) { const int t = colt / split_cols; base += (size_t)t * split_stride; colt -= t * split_cols; if (t == 0) sc = scale0; }
        const int col0 = colt + wc * 32 + 8 * fq, bcol0 = u.pn * BM + wc * 32 + 8 * fq;
        f32x4 bv[2][2];
#pragma unroll
        for (int bj = 0; bj < 2; ++bj)
#pragma unroll
            for (int n = 0; n < 2; ++n) bv[bj][n] = bias ? *(const f32x4*)(bias + bcol0 + bj * HALF + 4 * n) : (f32x4){0.f, 0.f, 0.f, 0.f};
#pragma unroll
        for (int ai = 0; ai < 2; ++ai)
#pragma unroll
            for (int m = 0; m < 4; ++m) { bf16_t* rowp = base + (size_t)(row0 + ai * HALF + m * 16) * ldc + col0;
#pragma unroll
                for (int bj = 0; bj < 2; ++bj) { f32x4 v0 = acc[ai][bj][m][0] + bv[bj][0], v1 = acc[ai][bj][m][1] + bv[bj][1];
                    if (ACT == 1) { f32x2 a = gelu_pk((f32x2){v0[0], v0[1]}), b = gelu_pk((f32x2){v0[2], v0[3]}), c = gelu_pk((f32x2){v1[0], v1[1]}), d = gelu_pk((f32x2){v1[2], v1[3]});
                        v0 = (f32x4){a.x, a.y, b.x, b.y}; v1 = (f32x4){c.x, c.y, d.x, d.y}; }
                    v0 = v0 * sc; v1 = v1 * sc; u32x4 w; w.x = cvt_pk_bf16(v0[0], v0[1]); w.y = cvt_pk_bf16(v0[2], v0[3]); w.z = cvt_pk_bf16(v1[0], v1[1]); w.w = cvt_pk_bf16(v1[2], v1[3]);
                    *(u32x4*)(rowp + bj * HALF) = w; } }
    }
};
__device__ __forceinline__ float silu_f(float x) { return x * __builtin_amdgcn_rcpf(1.0f + __builtin_amdgcn_exp2f(-1.4426950408889634f * x)); }
struct EpiResF32 {
    static constexpr bool PERM = false, AFTER_DRAIN = false;
    const float* base; float* out; int ldc; int pad;
    __device__ __forceinline__ void operator()(const f32x4 (&acc)[2][2][4][2], const Unit& u, int wr, int wc, int fr, int fq) const {
        const int row0 = u.pm * BM + wr * 64 + fr, col0 = u.pn * BM + wc * 32 + 4 * fq;
#pragma unroll
        for (int ai = 0; ai < 2; ++ai)
#pragma unroll
            for (int m = 0; m < 4; ++m) { const size_t off = (size_t)(row0 + ai * HALF + m * 16) * ldc + col0;
#pragma unroll
                for (int bj = 0; bj < 2; ++bj)
#pragma unroll
                    for (int n = 0; n < 2; ++n) { const f32x4 b = *(const f32x4*)(base + off + bj * HALF + n * 16); *(f32x4*)(out + off + bj * HALF + n * 16) = b + acc[ai][bj][m][n]; } }
    }
};
struct EpiSwiGLU {
    static constexpr bool PERM = true, AFTER_DRAIN = false;
    bf16_t* O; int ldc; int pad;
    __device__ __forceinline__ void operator()(const f32x4 (&acc)[2][2][4][2], const Unit& u, int wr, int wc, int fr, int fq) const {
        const int row0 = u.pm * BM + wr * 64 + fr, col0 = u.pn * HALF + wc * 32 + 8 * fq;
#pragma unroll
        for (int ai = 0; ai < 2; ++ai)
#pragma unroll
            for (int m = 0; m < 4; ++m) { bf16_t* rowp = O + (size_t)(row0 + ai * HALF + m * 16) * ldc + col0;
                const f32x4 g0 = acc[ai][0][m][0], g1 = acc[ai][0][m][1], u0 = acc[ai][1][m][0], u1 = acc[ai][1][m][1];
                u32x4 w;
                w.x = cvt_pk_bf16(silu_f(g0[0]) * u0[0], silu_f(g0[1]) * u0[1]); w.y = cvt_pk_bf16(silu_f(g0[2]) * u0[2], silu_f(g0[3]) * u0[3]);
                w.z = cvt_pk_bf16(silu_f(g1[0]) * u1[0], silu_f(g1[1]) * u1[1]); w.w = cvt_pk_bf16(silu_f(g1[2]) * u1[2], silu_f(g1[3]) * u1[3]);
                *(u32x4*)rowp = w; }
    }
};
template <class Epi, class Sched, bool ALIGN_EPI = false, bool SP2 = false>
__device__ __forceinline__ void gemm_phase(PG8_LAS unsigned char* lds, const Gemm g, const Sched& S, const Epi& E) {
    const int tid = threadIdx.x, wid = __builtin_amdgcn_readfirstlane(tid >> 6), lane = tid & 63, wr = wid >> 2, wc = wid & 3, fr = lane & 15, fq = lane >> 4;
    const int K = g.K, nt = K / BK;
    unsigned voffA[2], voffB[2];
#pragma unroll
    for (int i = 0; i < 2; ++i) { int R, C; stage_rc(tid * 16 + i * 8192, R, C); const int Rb = Epi::PERM ? ((R & ~31) + perm32(R & 31)) : R;
        voffA[i] = (unsigned)(R * K + C) * 2u; voffB[i] = (unsigned)(Rb * K + C) * 2u; }
    const size_t kstep = (size_t)(BK * 2);
    const size_t hstep = (size_t)HALF * K * 2;
    const size_t tstep = 2 * hstep;
    const unsigned ldsw = (unsigned)wid * 1024u;
    const int aoff = lds_byte(wr * 64 + fr, fq * 8), boff = lds_byte(wc * 32 + fr, fq * 8);
#define PG8_SA(b, h) (((b) * 2 + (h)) * HTB)
#define PG8_SB(b, h) ((4 + (b) * 2 + (h)) * HTB)
#define PG8_STAGE(bufoff, gbase, voff) do { _Pragma("unroll") for (int _i = 0; _i < 2; ++_i) \
        __builtin_amdgcn_global_load_lds((const unsigned*)((const char*)(gbase) + (voff)[_i]), (PG8_LAS unsigned*)(lds + (bufoff) + ldsw + _i * 8192), 16, 0, 0); } while (0)
#define PG8_LDA(dst, b, h) do { _Pragma("unroll") for (int m = 0; m < 4; ++m) _Pragma("unroll") for (int k = 0; k < 2; ++k) dst[m][k] = *(const PG8_LAS bf16x8*)(lds + PG8_SA(b, h) + aoff + m * 2048 + k * 1024); } while (0)
#define PG8_LDB(dst, b, h) do { _Pragma("unroll") for (int n = 0; n < 2; ++n) _Pragma("unroll") for (int k = 0; k < 2; ++k) dst[n][k] = *(const PG8_LAS bf16x8*)(lds + PG8_SB(b, h) + boff + n * 2048 + k * 1024); } while (0)
#define PG8_MMA(ai, bj, At, Bt) do { __builtin_amdgcn_s_setprio(1); _Pragma("unroll") for (int m = 0; m < 4; ++m) _Pragma("unroll") for (int n = 0; n < 2; ++n) _Pragma("unroll") for (int k = 0; k < 2; ++k) \
        acc[ai][bj][m][n] = __builtin_amdgcn_mfma_f32_16x16x32_bf16(Bt[n][k], At[m][k], acc[ai][bj][m][n], 0, 0, 0); __builtin_amdgcn_s_setprio(0); } while (0)
#define PG8_WAIT_V(n) asm volatile("s_waitcnt vmcnt(" #n ")" ::: "memory")
#define PG8_WAIT_L(n) asm volatile("s_waitcnt lgkmcnt(" #n ")" ::: "memory")
#define PG8_BAR __builtin_amdgcn_s_barrier()
#define PG8_SCHED __builtin_amdgcn_sched_barrier(0)
    Unit cur, nxt; int ui = 0;
    if (!S.next(0, cur)) return;
    f32x4 acc[2][2][4][2];
#pragma unroll
    for (int a = 0; a < 2; ++a)
#pragma unroll
        for (int b = 0; b < 2; ++b)
#pragma unroll
            for (int m = 0; m < 4; ++m)
#pragma unroll
                for (int n = 0; n < 2; ++n) acc[a][b][m][n] = (f32x4){0.f, 0.f, 0.f, 0.f};
    bf16x8 At[4][2], B0[2][2], B1[2][2];
    const char* cA = (const char*)g.A + (size_t)cur.pm * tstep; const char* cB = (const char*)g.Bt + (size_t)cur.pn * tstep;
    S.a_ready(cur);
    if constexpr (SP2) {
        PG8_STAGE(PG8_SB(0, 0), cB, voffB); PG8_STAGE(PG8_SB(0, 1), cB + hstep, voffB); PG8_STAGE(PG8_SA(0, 0), cA, voffA); PG8_STAGE(PG8_SA(0, 1), cA + hstep, voffA);
        if (wr == 1) PG8_BAR;
        PG8_WAIT_V(2); PG8_BAR;
        PG8_STAGE(PG8_SB(1, 0), cB + kstep, voffB); PG8_STAGE(PG8_SA(1, 0), cA + kstep, voffA); PG8_STAGE(PG8_SB(1, 1), cB + hstep + kstep, voffB);
        PG8_WAIT_V(6); PG8_BAR;
    } else {
        PG8_STAGE(PG8_SB(0, 0), cB, voffB); PG8_STAGE(PG8_SA(0, 0), cA, voffA); PG8_STAGE(PG8_SB(0, 1), cB + hstep, voffB); PG8_STAGE(PG8_SA(0, 1), cA + hstep, voffA);
        if (wr == 1) PG8_BAR;
        PG8_WAIT_V(4); PG8_BAR;
        PG8_STAGE(PG8_SB(1, 0), cB + kstep, voffB); PG8_STAGE(PG8_SA(1, 0), cA + kstep, voffA); PG8_STAGE(PG8_SB(1, 1), cB + hstep + kstep, voffB);
        PG8_WAIT_V(6); PG8_BAR;
    }
    for (;;) {
        const bool has_next = S.next(ui + 1, nxt);
        const char* nA = has_next ? (const char*)g.A + (size_t)nxt.pm * tstep : cA; const char* nB = has_next ? (const char*)g.Bt + (size_t)nxt.pn * tstep : cB;
        for (int t = 0; t < nt; t += 2) {
            const bool last = (t == nt - 2);
            const char* a1 = cA + (size_t)(t + 1) * kstep;
            const char* a2 = last ? nA : cA + (size_t)(t + 2) * kstep; const char* b2 = last ? nB : cB + (size_t)(t + 2) * kstep;
            const char* a3 = a2 + kstep; const char* b3 = b2 + kstep;
            if (last && has_next) S.a_ready(nxt);
            if constexpr (SP2) {
            PG8_LDB(B0, 0, 0); PG8_LDB(B1, 0, 1); PG8_SCHED; PG8_LDA(At, 0, 0); PG8_STAGE(PG8_SA(1, 1), a1 + hstep, voffA);
            PG8_WAIT_V(8); PG8_WAIT_L(0); PG8_BAR; PG8_MMA(0, 0, At, B0); PG8_MMA(0, 1, At, B1); PG8_BAR; PG8_SCHED;
            PG8_LDA(At, 0, 1); PG8_STAGE(PG8_SB(0, 0), b2, voffB); PG8_STAGE(PG8_SB(0, 1), b2 + hstep, voffB); PG8_STAGE(PG8_SA(0, 0), a2, voffA);
            PG8_WAIT_V(8); PG8_WAIT_L(0); PG8_BAR; PG8_MMA(1, 0, At, B0); PG8_MMA(1, 1, At, B1); PG8_BAR; PG8_SCHED;
            PG8_LDB(B0, 1, 0); PG8_LDB(B1, 1, 1); PG8_SCHED; PG8_LDA(At, 1, 0); PG8_STAGE(PG8_SA(0, 1), a2 + hstep, voffA);
            PG8_WAIT_V(8); PG8_WAIT_L(0); PG8_BAR; PG8_MMA(0, 0, At, B0); PG8_MMA(0, 1, At, B1); PG8_BAR; PG8_SCHED;
            PG8_LDA(At, 1, 1); PG8_STAGE(PG8_SB(1, 0), b3, voffB); PG8_STAGE(PG8_SB(1, 1), b3 + hstep, voffB); PG8_STAGE(PG8_SA(1, 0), a3, voffA);
            PG8_WAIT_V(8); PG8_WAIT_L(0); PG8_BAR; PG8_MMA(1, 0, At, B0); PG8_MMA(1, 1, At, B1); PG8_BAR; PG8_SCHED;
            } else {
            PG8_LDB(B0, 0, 0); PG8_SCHED; PG8_LDA(At, 0, 0); PG8_STAGE(PG8_SA(1, 1), a1 + hstep, voffA);
            PG8_WAIT_L(8); PG8_BAR; PG8_WAIT_L(0); PG8_MMA(0, 0, At, B0); PG8_BAR; PG8_SCHED;
            PG8_LDB(B1, 0, 1); PG8_STAGE(PG8_SB(0, 0), b2, voffB);
            PG8_BAR; PG8_WAIT_L(0); PG8_MMA(0, 1, At, B1); PG8_BAR;
            PG8_LDA(At, 0, 1); PG8_STAGE(PG8_SA(0, 0), a2, voffA);
            PG8_BAR; PG8_WAIT_L(0); PG8_MMA(1, 0, At, B0); PG8_BAR; PG8_SCHED;
            PG8_STAGE(PG8_SB(0, 1), b2 + hstep, voffB);
            PG8_WAIT_V(6); PG8_BAR; PG8_MMA(1, 1, At, B1); PG8_BAR;
            PG8_LDB(B0, 1, 0); PG8_SCHED; PG8_LDA(At, 1, 0); PG8_STAGE(PG8_SA(0, 1), a2 + hstep, voffA);
            PG8_WAIT_L(8); PG8_BAR; PG8_WAIT_L(0); PG8_MMA(0, 0, At, B0); PG8_BAR; PG8_SCHED;
            PG8_LDB(B1, 1, 1); PG8_STAGE(PG8_SB(1, 0), b3, voffB);
            PG8_BAR; PG8_WAIT_L(0); PG8_MMA(0, 1, At, B1); PG8_BAR;
            PG8_LDA(At, 1, 1); PG8_STAGE(PG8_SA(1, 0), a3, voffA);
            PG8_BAR; PG8_WAIT_L(0); PG8_MMA(1, 0, At, B0); PG8_BAR; PG8_SCHED;
            PG8_STAGE(PG8_SB(1, 1), b3 + hstep, voffB);
            PG8_WAIT_V(6); PG8_BAR; PG8_MMA(1, 1, At, B1); PG8_BAR;
            }
        }
        if constexpr (ALIGN_EPI) { if (wr == 0) PG8_BAR; }
        if constexpr (!Epi::AFTER_DRAIN) { E(acc, cur, wr, wc, fr, fq); S.done(cur); }
        if (!has_next) break;
#pragma unroll
        for (int a = 0; a < 2; ++a)
#pragma unroll
            for (int b = 0; b < 2; ++b)
#pragma unroll
                for (int m = 0; m < 4; ++m)
#pragma unroll
                    for (int n = 0; n < 2; ++n) acc[a][b][m][n] = (f32x4){0.f, 0.f, 0.f, 0.f};
        cur = nxt; cA = nA; cB = nB; ++ui;
        if constexpr (ALIGN_EPI) { if (wr == 1) PG8_BAR; }
    }
    PG8_WAIT_V(0);
    if constexpr (!ALIGN_EPI) { if (wr == 0) PG8_BAR; }
    PG8_BAR;
    if constexpr (Epi::AFTER_DRAIN) { E.fused(acc, cur, wr, wc, fr, fq, lds, wid, lane); S.done(cur); }
#undef PG8_SA
#undef PG8_SB
#undef PG8_STAGE
#undef PG8_LDA
#undef PG8_LDB
#undef PG8_MMA
#undef PG8_WAIT_V
#undef PG8_WAIT_L
#undef PG8_BAR
#undef PG8_SCHED
}
}
constexpr int DM = 1024, NB = 16, SEQ = 2048, M = NB * SEQ, DEPTH = 2;
constexpr int NPROJ = 2560, INCOLS = 2564, DFF = 2816, NGU = 2 * DFF;
constexpr float EPS = 1e-6f;
constexpr size_t MiB = 1u << 20;
constexpr size_t WS_WIN = 2 * MiB, WS_WOUT = 12 * MiB, WS_WGU = 16 * MiB, WS_WDN = 38 * MiB, WS_DT = 49 * MiB;
constexpr size_t WS_XN = 64 * MiB, WS_PROJ = 128 * MiB, WS_MIX = 288 * MiB, WS_HID = 128 * MiB, WS_XBC = 352 * MiB, WS_YSSD = 448 * MiB, WS_END = 480 * MiB;
typedef unsigned short bf16;
typedef float f32x4 __attribute__((ext_vector_type(4)));
typedef unsigned v4u __attribute__((ext_vector_type(4)));
__device__ __forceinline__ unsigned f2bf(float f) { unsigned u = __builtin_bit_cast(unsigned, f); return (u + 0x7fffu + ((u >> 16) & 1u)) >> 16; }
__device__ __forceinline__ unsigned pk2(float lo, float hi) { return f2bf(lo) | (f2bf(hi) << 16); }
__device__ __forceinline__ float bf2f(bf16 u) { return __builtin_bit_cast(float, (unsigned)u << 16); }
__device__ __forceinline__ float wave_sum(float v) {
#pragma unroll
    for (int o = 1; o < 64; o <<= 1) v += __shfl_xor(v, o);
    return v;
}
__device__ __forceinline__ float silu_acc(float x) { return x / (1.0f + expf(-x)); }

__global__ void __launch_bounds__(256) transpose_kernel(const float* W, int K, int ldn, int nblk, bf16* WT, int mode) {
    __shared__ float scr_all[4][64 * 33];
    const int lane = threadIdx.x & 63, wave = threadIdx.x >> 6;
    float* scr = scr_all[wave];
    const int nitems = (K / 64) * nblk;
    for (int item = blockIdx.x * 4 + wave; item < nitems; item += gridDim.x * 4) {
        const int kb = item / nblk, nb = item % nblk, k0 = 64 * kb, n0 = 32 * nb;
        for (int i = 0; i < 32; ++i) { const int kk = 2 * i + (lane >> 5); scr[kk * 33 + (lane & 31)] = W[(size_t)(k0 + kk) * ldn + n0 + (lane & 31)]; }
        __builtin_amdgcn_wave_barrier(); asm volatile("s_waitcnt lgkmcnt(0)" ::: "memory");
        const int c = lane & 7;
        for (int j = 0; j < 4; ++j) { const int n = (lane >> 3) + 8 * j; const float* s = scr + (8 * c) * 33 + n;
            v4u o; o.x = pk2(s[0 * 33], s[1 * 33]); o.y = pk2(s[2 * 33], s[3 * 33]); o.z = pk2(s[4 * 33], s[5 * 33]); o.w = pk2(s[6 * 33], s[7 * 33]);
            const int ng = n0 + n; const int drow = (mode == 0) ? ng : (((ng >> 7) << 8) + (mode == 2 ? 128 : 0) + (ng & 127));
            *(v4u*)(WT + (size_t)drow * K + k0 + 8 * c) = o; }
        __builtin_amdgcn_wave_barrier(); asm volatile("s_waitcnt lgkmcnt(0)" ::: "memory");
    }
}

__global__ void __launch_bounds__(512) rowpass_kernel(const float* h, const float* g, bf16* xn, const float* wdt, float* dt) {
    const int row = blockIdx.x * 8 + (threadIdx.x >> 6), lane = threadIdx.x & 63;
    const f32x4* hr = (const f32x4*)(h + (size_t)row * DM) + lane;
    f32x4 v[4]; float s = 0.f;
#pragma unroll
    for (int j = 0; j < 4; ++j) { v[j] = hr[64 * j]; s += (v[j].x * v[j].x + v[j].y * v[j].y) + (v[j].z * v[j].z + v[j].w * v[j].w); }
    const float rstd = 1.0f / sqrtf(wave_sum(s) * (1.0f / DM) + EPS);
    const f32x4* gr = (const f32x4*)g + lane;
    unsigned long long* o8 = (unsigned long long*)(xn + (size_t)row * DM) + lane;
    f32x4 d = {0.f, 0.f, 0.f, 0.f};
#pragma unroll
    for (int j = 0; j < 4; ++j) { const f32x4 y = v[j] * rstd * gr[64 * j];
        o8[64 * j] = (unsigned long long)pk2(y.x, y.y) | ((unsigned long long)pk2(y.z, y.w) << 32);
        if (wdt) { const int k = 4 * (lane + 64 * j);
#pragma unroll
            for (int e = 0; e < 4; ++e) d += y[e] * *(const f32x4*)(wdt + (size_t)(k + e) * INCOLS); } }
    if (wdt) { d.x = wave_sum(d.x); d.y = wave_sum(d.y); d.z = wave_sum(d.z); d.w = wave_sum(d.w); if (lane == 0) *(f32x4*)(dt + (size_t)row * 4) = d; }
}
__global__ void __launch_bounds__(512) final_norm_kernel(float* h, const float* g) {
    const int row = blockIdx.x * 8 + (threadIdx.x >> 6), lane = threadIdx.x & 63;
    f32x4* hr = (f32x4*)(h + (size_t)row * DM) + lane;
    f32x4 v[4]; float s = 0.f;
#pragma unroll
    for (int j = 0; j < 4; ++j) { v[j] = hr[64 * j]; s += (v[j].x * v[j].x + v[j].y * v[j].y) + (v[j].z * v[j].z + v[j].w * v[j].w); }
    const float rstd = 1.0f / sqrtf(wave_sum(s) * (1.0f / DM) + EPS);
    const f32x4* gr = (const f32x4*)g + lane;
#pragma unroll
    for (int j = 0; j < 4; ++j) hr[64 * j] = v[j] * rstd * gr[64 * j];
}

__global__ void __launch_bounds__(256) pool_kernel(const bf16* proj, const float* w, const float* bias, const float* scale, bf16* mix) {
    __shared__ float pooled[8][256];
    const int c = threadIdx.x, g = c >> 6, win = 2 << g, tok0 = blockIdx.x * 8;
    for (int i = 0; i < 8; ++i) { const int tok = tok0 + i, t = tok & (SEQ - 1); const int cnt = (t + 1 < win) ? t + 1 : win; float s = 0.f;
        for (int k = 0; k < cnt; ++k) s += bf2f(proj[(size_t)(tok - k) * NPROJ + c]);
        pooled[i][c] = s / (float)cnt - bf2f(proj[(size_t)tok * NPROJ + c]); }
    __syncthreads();
    const int d = c & 63;
    for (int i = 0; i < 8; ++i) { float acc = 0.f;
        for (int cc = 0; cc < 64; ++cc) acc += pooled[i][g * 64 + cc] * w[(g * 64 + cc) * 64 + d];
        mix[(size_t)(tok0 + i) * DM + c] = (bf16)f2bf((acc + bias[c]) * scale[c]); }
}
__global__ void __launch_bounds__(256) sgu_kernel(const bf16* proj, const float* ln_g, const float* ln_b, const float* sw, const float* sb, bf16* mix) {
    extern __shared__ float vn[];
    const int tok0 = blockIdx.x * 128, lane = threadIdx.x & 63, wave = threadIdx.x >> 6;
    for (int i = wave; i < 128; i += 4) { float v[4]; float s = 0.f;
        for (int e = 0; e < 4; ++e) { v[e] = bf2f(proj[(size_t)(tok0 + i) * NPROJ + 512 + lane * 4 + e]); s += v[e]; }
        const float mu = wave_sum(s) * (1.0f / 256.0f); float q = 0.f;
        for (int e = 0; e < 4; ++e) { v[e] -= mu; q += v[e] * v[e]; }
        const float rs = 1.0f / sqrtf(wave_sum(q) * (1.0f / 256.0f) + EPS);
        for (int e = 0; e < 4; ++e) vn[i * 256 + lane * 4 + e] = v[e] * rs * ln_g[lane * 4 + e] + ln_b[lane * 4 + e]; }
    __syncthreads();
    const int c = threadIdx.x, h = c >> 6;
    for (int i = 0; i < 128; ++i) { const int jmax = (i < 64) ? 64 : 128; float acc = sb[h * 128 + i];
        for (int j = 0; j < jmax; ++j) acc += sw[(h * 128 + i) * 128 + j] * vn[j * 256 + c];
        const float u = bf2f(proj[(size_t)(tok0 + i) * NPROJ + 256 + c]);
        mix[(size_t)(tok0 + i) * DM + 256 + c] = (bf16)f2bf(u * acc); }
}
__global__ void __launch_bounds__(256) sconv_kernel(const bf16* proj, const float* w, bf16* mix) {
    const int tok = blockIdx.x, c = threadIdx.x, t = tok & (SEQ - 1);
    float acc = 0.f;
    for (int k = 0; k < 3; ++k) { const int tt = t - 2 + k; if (tt >= 0) { const bf16* r = proj + (size_t)(tok - 2 + k) * NPROJ; acc += w[k * 256 + c] * (bf2f(r[1024 + c]) * bf2f(r[1280 + c])); } }
    mix[(size_t)tok * DM + 512 + c] = (bf16)f2bf(bf2f(proj[(size_t)tok * NPROJ + 768 + c]) * acc);
}
__global__ void __launch_bounds__(256) ssdconv_kernel(const bf16* proj, const float* cw, const float* cb, float* xbc) {
    const int tok = blockIdx.x, t = tok & (SEQ - 1);
    for (int ch = threadIdx.x; ch < 768; ch += 256) { float acc = cb[ch];
        for (int k = 0; k < 4; ++k) { const int tt = t - 3 + k; if (tt >= 0) acc += cw[k * 768 + ch] * bf2f(proj[(size_t)(tok - 3 + k) * NPROJ + 1792 + ch]); }
        xbc[(size_t)tok * 768 + ch] = silu_acc(acc); }
}
__global__ void __launch_bounds__(64) ssdscan_kernel(const float* xbc, const float* dt, const float* dt_bias, const float* a_log, const float* dsk, float* yssd) {
    __shared__ float Bs[128], Cs[128];
    const int b = blockIdx.x >> 2, h = blockIdx.x & 3, g = h >> 1, p = threadIdx.x;
    const float a = -expf(a_log[h]), dtb = dt_bias[h], D = dsk[h];
    float s[128];
#pragma unroll
    for (int n = 0; n < 128; ++n) s[n] = 0.f;
    for (int t = 0; t < SEQ; ++t) { const size_t tok = (size_t)b * SEQ + t;
        __syncthreads();
        Bs[p] = xbc[tok * 768 + 256 + g * 128 + p]; Bs[p + 64] = xbc[tok * 768 + 256 + g * 128 + 64 + p];
        Cs[p] = xbc[tok * 768 + 512 + g * 128 + p]; Cs[p + 64] = xbc[tok * 768 + 512 + g * 128 + 64 + p];
        __syncthreads();
        const float dv = dt[tok * 4 + h] + dtb; const float delta = dv > 20.f ? dv : log1pf(expf(dv));
        const float dA = expf(delta * a), x = xbc[tok * 768 + h * 64 + p], xd = x * delta; float y = 0.f;
#pragma unroll
        for (int n = 0; n < 128; ++n) { s[n] = s[n] * dA + xd * Bs[n]; y += Cs[n] * s[n]; }
        yssd[tok * 256 + h * 64 + p] = y + D * x; }
}
__global__ void __launch_bounds__(256) ssdout_kernel(const bf16* proj, const float* yssd, const float* ng, bf16* mix) {
    const int tok = blockIdx.x * 4 + (threadIdx.x >> 6), lane = threadIdx.x & 63;
    float y[4]; float q = 0.f;
    for (int e = 0; e < 4; ++e) { const int ch = lane * 4 + e; const float z = bf2f(proj[(size_t)tok * NPROJ + 1536 + ch]); y[e] = yssd[(size_t)tok * 256 + ch] * silu_acc(z); q += y[e] * y[e]; }
#pragma unroll
    for (int o = 1; o < 32; o <<= 1) q += __shfl_xor(q, o);
    const float rs = 1.0f / sqrtf(q * (1.0f / 128.0f) + EPS);
    for (int e = 0; e < 4; ++e) { const int ch = lane * 4 + e; mix[(size_t)tok * DM + 768 + ch] = (bf16)f2bf(y[e] * rs * ng[ch]); }
}

constexpr int LDS_BYTES = 147456;
template <class Epi> __global__ void __launch_bounds__(512, 2) gemm_kernel(pg8::Gemm g, Epi E) {
    extern __shared__ __attribute__((aligned(16))) unsigned char lds[];
    pg8::StaticOrder S; S.init(g.M, g.N, (int)gridDim.x, (int)blockIdx.x);
    pg8::gemm_phase<Epi, pg8::StaticOrder, true, true>((PG8_LAS unsigned char*)lds, g, S, E);
}
template <class Epi> static void launch_gemm(const pg8::Gemm& g, const Epi& E, hipStream_t stream) {
    static bool attr = false;
    if (!attr) { (void)hipFuncSetAttribute((const void*)gemm_kernel<Epi>, hipFuncAttributeMaxDynamicSharedMemorySize, LDS_BYTES); attr = true; }
    hipLaunchKernelGGL(gemm_kernel<Epi>, dim3(256), dim3(512), LDS_BYTES, stream, g, E);
}

extern "C" void kernel_launch(void* const* d_in, const int* in_sizes, int n_in, void* d_out, int out_size, void* d_ws, size_t ws_size, hipStream_t stream) {
    if (n_in != 23 || out_size != M * DM || ws_size < WS_END) { fprintf(stderr, "kernel_launch: unexpected shapes (n_in %d out %d ws %zu)\n", n_in, out_size, ws_size); return; }
    const float* const* in = (const float* const*)d_in;
    unsigned char* ws = (unsigned char*)d_ws; float* out = (float*)d_out;
    bf16* XN = (bf16*)(ws + WS_XN); bf16* PROJ = (bf16*)(ws + WS_PROJ); bf16* MIX = (bf16*)(ws + WS_MIX); bf16* HID = (bf16*)(ws + WS_HID);
    float* DT = (float*)(ws + WS_DT); float* XBC = (float*)(ws + WS_XBC); float* YSSD = (float*)(ws + WS_YSSD);
    static bool attr = false;
    if (!attr) { (void)hipFuncSetAttribute((const void*)sgu_kernel, hipFuncAttributeMaxDynamicSharedMemorySize, 131072); attr = true; }
    for (int l = 0; l < DEPTH; ++l) {
        bf16* win_t = (bf16*)(ws + WS_WIN) + (size_t)l * NPROJ * DM; bf16* wout_t = (bf16*)(ws + WS_WOUT) + (size_t)l * DM * DM;
        bf16* wgu_t = (bf16*)(ws + WS_WGU) + (size_t)l * NGU * DM; bf16* wdn_t = (bf16*)(ws + WS_WDN) + (size_t)l * DM * DFF;
        hipLaunchKernelGGL(transpose_kernel, dim3(320), dim3(256), 0, stream, in[2] + (size_t)l * DM * INCOLS, DM, INCOLS, NPROJ / 32, win_t, 0);
        hipLaunchKernelGGL(transpose_kernel, dim3(128), dim3(256), 0, stream, in[17] + (size_t)l * DM * DM, DM, DM, DM / 32, wout_t, 0);
        hipLaunchKernelGGL(transpose_kernel, dim3(352), dim3(256), 0, stream, in[19] + (size_t)l * DM * DFF, DM, DFF, DFF / 32, wgu_t, 1);
        hipLaunchKernelGGL(transpose_kernel, dim3(352), dim3(256), 0, stream, in[20] + (size_t)l * DM * DFF, DM, DFF, DFF / 32, wgu_t, 2);
        hipLaunchKernelGGL(transpose_kernel, dim3(352), dim3(256), 0, stream, in[21] + (size_t)l * DFF * DM, DFF, DM, DM / 32, wdn_t, 0);
    }
    for (int l = 0; l < DEPTH; ++l) {
        bf16* win_t = (bf16*)(ws + WS_WIN) + (size_t)l * NPROJ * DM; bf16* wout_t = (bf16*)(ws + WS_WOUT) + (size_t)l * DM * DM;
        bf16* wgu_t = (bf16*)(ws + WS_WGU) + (size_t)l * NGU * DM; bf16* wdn_t = (bf16*)(ws + WS_WDN) + (size_t)l * DM * DFF;
        const float* hin = (l == 0) ? in[0] : out;
        hipLaunchKernelGGL(rowpass_kernel, dim3(M / 8), dim3(512), 0, stream, hin, in[1] + l * DM, XN, in[2] + (size_t)l * DM * INCOLS + NPROJ, DT);
        launch_gemm(pg8::Gemm{XN, win_t, M, NPROJ, DM, 0}, pg8::EpiBf16<0>{PROJ, nullptr, 0, NPROJ, 0, 1.f, 0}, stream);
        hipLaunchKernelGGL(pool_kernel, dim3(M / 8), dim3(256), 0, stream, PROJ, in[3] + l * 4 * 64 * 64, in[4] + l * 256, in[5] + l * 256, MIX);
        hipLaunchKernelGGL(sgu_kernel, dim3(M / 128), dim3(256), 131072, stream, PROJ, in[6] + l * 256, in[7] + l * 256, in[8] + l * 4 * 128 * 128, in[9] + l * 4 * 128, MIX);
        hipLaunchKernelGGL(sconv_kernel, dim3(M), dim3(256), 0, stream, PROJ, in[10] + l * 3 * 256, MIX);
        hipLaunchKernelGGL(ssdconv_kernel, dim3(M), dim3(256), 0, stream, PROJ, in[11] + l * 4 * 768, in[12] + l * 768, XBC);
        hipLaunchKernelGGL(ssdscan_kernel, dim3(NB * 4), dim3(64), 0, stream, XBC, DT, in[13] + l * 4, in[14] + l * 4, in[15] + l * 4, YSSD);
        hipLaunchKernelGGL(ssdout_kernel, dim3(M / 4), dim3(256), 0, stream, PROJ, YSSD, in[16] + l * 256, MIX);
        launch_gemm(pg8::Gemm{MIX, wout_t, M, DM, DM, 0}, pg8::EpiResF32{hin, out, DM, 0}, stream);
        hipLaunchKernelGGL(rowpass_kernel, dim3(M / 8), dim3(512), 0, stream, (const float*)out, in[18] + l * DM, XN, (const float*)nullptr, (float*)nullptr);
        launch_gemm(pg8::Gemm{XN, wgu_t, M, NGU, DM, 0}, pg8::EpiSwiGLU{HID, DFF, 0}, stream);
        launch_gemm(pg8::Gemm{HID, wdn_t, M, DM, DFF, 0}, pg8::EpiResF32{out, out, DM, 0}, stream);
    }
    hipLaunchKernelGGL(final_norm_kernel, dim3(M / 8), dim3(512), 0, stream, out, in[22]);
}
```

```cpp
#include <hip/hip_runtime.h>
#include <cstdio>
#include <cstdint>
#ifndef NGROUPS
#define NGROUPS 8
#endif
#ifndef GROUP_SPREAD
#define GROUP_SPREAD 0
#endif
#define PG8_NXCD (GROUP_SPREAD ? 8 : 8 / NGROUPS)
#ifndef PG8_WGM
#define PG8_WGM (GROUP_SPREAD ? 1 : 8)
#endif
#define P_STRIDE 32768
#ifndef NT_STORES
#define NT_STORES 4
#endif
#ifndef EPI_TEST
#define EPI_TEST 0
#endif
template <int MASK> __device__ __forceinline__ float lane_xor(float v) {
    static_assert(MASK > 0 && MASK < 32, "lane_xor: MASK 1..31");
    return __builtin_bit_cast(float, __builtin_amdgcn_ds_swizzle(__builtin_bit_cast(int, v), (MASK << 10) | 0x1f));
}
template <int CTRL> __device__ __forceinline__ float dpp_f(float v) {
    return __builtin_bit_cast(float, __builtin_amdgcn_update_dpp(0, __builtin_bit_cast(int, v), CTRL, 0xF, 0xF, true));
}
__device__ __forceinline__ float add_xor32(float v) {
    const auto r = __builtin_amdgcn_permlane32_swap(__builtin_bit_cast(unsigned, v), __builtin_bit_cast(unsigned, v), false, false);
    return __builtin_bit_cast(float, (unsigned)r[0]) + __builtin_bit_cast(float, (unsigned)r[1]);
}
namespace pg8 {
#define PG8_LAS __attribute__((address_space(3)))
typedef unsigned short bf16_t;
typedef short bf16x8 __attribute__((ext_vector_type(8)));
typedef float f32x4 __attribute__((ext_vector_type(4)));
typedef unsigned u32x4 __attribute__((ext_vector_type(4)));
constexpr int BM = 256, BK = 64, HALF = 128, HTB = HALF * BK * 2  , STAGE_BYTES = 8 * HTB, NXCD = PG8_NXCD, WGM = PG8_WGM;

__host__ __device__ __forceinline__ int lds_byte(int r, int c) { const int st = (r >> 4) * 2 + (c >> 5), rr = r & 15, cc = c & 31, ob = rr * 64 + cc * 2; return st * 1024 + (ob ^ (((ob >> 9) & 1) << 5)); }
__host__ __device__ __forceinline__ void stage_rc(int b, int& R, int& C) { const int st = b / 1024, sb = b % 1024, swz = sb ^ (((sb >> 9) & 1) << 5); R = (st >> 1) * 16 + swz / 64; C = (st & 1) * 32 + (swz % 64) / 2; }
__host__ __device__ __forceinline__ int perm32(int rho) { const int n = rho >> 4, i = rho & 15; return 8 * (i >> 2) + 4 * n + (i & 3); }

struct Unit { int pm, pn; };
struct Gemm { const bf16_t* A; const bf16_t* Bt; int M, N, K, pad; };

struct StaticOrder {
    int nM, nN, nwg, G, c;
    __host__ __device__ void init(int M, int N, int G_, int c_) { nM = M / BM; nN = N / BM; nwg = nM * nN; G = G_; c = c_; }
    __host__ __device__ bool next(int i, Unit& u) const {
        const long L = (long)i * G + c; if (L >= nwg) return false;
        int wgid = (int)L; { const int q = nwg / NXCD, r = nwg % NXCD, xcd = wgid % NXCD, off = wgid / NXCD; wgid = (xcd < r ? xcd * (q + 1) : r * (q + 1) + (xcd - r) * q) + off; }
        const int nig = WGM * nN, gid = wgid / nig, fm = gid * WGM, gsz = (nM - fm) < WGM ? (nM - fm) : WGM;
        u.pm = fm + ((wgid % nig) % gsz); u.pn = (wgid % nig) / gsz; return true;
    }
    __device__ __forceinline__ void a_ready(const Unit&) const {}
    __device__ __forceinline__ void done(const Unit&) const {}
};

__device__ __forceinline__ unsigned cvt_pk_bf16(float lo, float hi) { unsigned r; asm volatile("v_cvt_pk_bf16_f32 %0, %1, %2" : "=v"(r) : "v"(lo), "v"(hi)); return r; }
typedef float f32x2 __attribute__((ext_vector_type(2)));
__device__ __forceinline__ f32x2 gelu_pk(f32x2 v) {
    const f32x2 av = __builtin_elementwise_abs(v), d = av * 0.2316418882f + 1.0f;
    f32x2 t; t.x = __builtin_amdgcn_rcpf(d.x); t.y = __builtin_amdgcn_rcpf(d.y);
    f32x2 q = t * 0.5307027145f + (-0.7265760135f); q = q * t + 0.7107068705f; q = q * t + (-0.142248368f); q = q * t + 0.127414796f; q = q * t;
    const f32x2 s = (v * v) * (-0.72134752044f);
    f32x2 e; e.x = __builtin_amdgcn_exp2f(s.x); e.y = __builtin_amdgcn_exp2f(s.y);
    const f32x2 m = v * (q * e), r = v - m;
    f32x2 o; o.x = v.x < 0.f ? m.x : r.x; o.y = v.y < 0.f ? m.y : r.y; return o;
}

template <int ACT  > struct EpiBf16 {
    static constexpr bool PERM = true, AFTER_DRAIN = false; static_assert(ACT == 0 || ACT == 1, "EpiBf16: ACT is 0 (none) or 1 (gelu_pk)");
    bf16_t* O; const float* bias; size_t split_stride; int ldc; int split_cols; float scale0; int pad;
    __device__ __forceinline__ void operator()(const f32x4 (&acc)[2][2][4][2], const Unit& u, int wr, int wc, int fr, int fq) const {
        const int row0 = u.pm * BM + wr * 64 + fr; int colt = u.pn * BM; bf16_t* base = O;
        float sc = 1.f; if (split_cols) { const int t = colt / split_cols; base += (size_t)t * split_stride; colt -= t * split_cols; if (t == 0) sc = scale0; }
        const int col0 = colt + wc * 32 + 8 * fq, bcol0 = u.pn * BM + wc * 32 + 8 * fq;
        f32x4 bv[2][2];
#pragma unroll
        for (int bj = 0; bj < 2; ++bj)
#pragma unroll
            for (int n = 0; n < 2; ++n) bv[bj][n] = bias ? *(const f32x4*)(bias + bcol0 + bj * HALF + 4 * n) : (f32x4){0.f, 0.f, 0.f, 0.f};
#pragma unroll
        for (int ai = 0; ai < 2; ++ai)
#pragma unroll
            for (int m = 0; m < 4; ++m) { bf16_t* rowp = base + (size_t)(row0 + ai * HALF + m * 16) * ldc + col0;
#pragma unroll
                for (int bj = 0; bj < 2; ++bj) { f32x4 v0 = acc[ai][bj][m][0] + bv[bj][0], v1 = acc[ai][bj][m][1] + bv[bj][1];
                    if (ACT == 1) { f32x2 a = gelu_pk((f32x2){v0[0], v0[1]}), b = gelu_pk((f32x2){v0[2], v0[3]}), c = gelu_pk((f32x2){v1[0], v1[1]}), d = gelu_pk((f32x2){v1[2], v1[3]});
                        v0 = (f32x4){a.x, a.y, b.x, b.y}; v1 = (f32x4){c.x, c.y, d.x, d.y}; }
                    v0 = v0 * sc; v1 = v1 * sc; u32x4 w; w.x = cvt_pk_bf16(v0[0], v0[1]); w.y = cvt_pk_bf16(v0[2], v0[3]); w.z = cvt_pk_bf16(v1[0], v1[1]); w.w = cvt_pk_bf16(v1[2], v1[3]);
                    *(u32x4*)(rowp + bj * HALF) = w; } }
    }
};
__device__ __forceinline__ float silu_f(float x) { return x * __builtin_amdgcn_rcpf(1.0f + __builtin_amdgcn_exp2f(-1.4426950408889634f * x)); }
template <bool STORE> struct EpiProjT {
    static constexpr bool PERM = true, AFTER_DRAIN = false;
    bf16_t* O; const PG8_LAS float* rt; int pmA; int ldc;
    float pv[16];
    __device__ __forceinline__ void pre() const {
        int t_ = threadIdx.x; asm volatile("" : "+v"(t_));
        float q[16];
#pragma unroll
        for (int i = 0; i < 16; ++i) q[i] = pv[i];
        asm volatile("" : "+v"(q[0]), "+v"(q[1]), "+v"(q[2]), "+v"(q[3]), "+v"(q[4]), "+v"(q[5]), "+v"(q[6]), "+v"(q[7]), "+v"(q[8]), "+v"(q[9]), "+v"(q[10]), "+v"(q[11]), "+v"(q[12]), "+v"(q[13]), "+v"(q[14]), "+v"(q[15]) :: "memory");
        float s = 0.f;
#pragma unroll
        for (int i = 0; i < 16; ++i) s += q[i];
        ((PG8_LAS float*)rt)[t_] = __builtin_amdgcn_rsqf(s * (1.0f / 1024.0f) + 1e-6f);
        __syncthreads();
    }
    __device__ __forceinline__ void operator()(const f32x4 (&acc)[2][2][4][2], const Unit& u, int wr, int wc, int fr, int fq) const {
        const int row0 = u.pm * BM + wr * 64 + fr, col0 = u.pn * BM + wc * 32 + 8 * fq; const PG8_LAS float* rtp = rt + (u.pm != pmA ? 256 : 0) + wr * 64 + fr;
        float rsv[8];
#pragma unroll
        for (int i = 0; i < 8; ++i) rsv[i] = rtp[(i >> 2) * HALF + (i & 3) * 16];
        asm volatile("" : "+v"(rsv[0]), "+v"(rsv[1]), "+v"(rsv[2]), "+v"(rsv[3]), "+v"(rsv[4]), "+v"(rsv[5]), "+v"(rsv[6]), "+v"(rsv[7]));
#pragma unroll
        for (int ai = 0; ai < 2; ++ai)
#pragma unroll
            for (int m = 0; m < 4; ++m) { const int row = row0 + ai * HALF + m * 16; const float rs = rsv[ai * 4 + m]; bf16_t* rowp = O + (size_t)row * ldc + col0;
#pragma unroll
                for (int bj = 0; bj < 2; ++bj) { const f32x4 v0 = acc[ai][bj][m][0] * rs, v1 = acc[ai][bj][m][1] * rs; u32x4 w;
                    w.x = cvt_pk_bf16(v0[0], v0[1]); w.y = cvt_pk_bf16(v0[2], v0[3]); w.z = cvt_pk_bf16(v1[0], v1[1]); w.w = cvt_pk_bf16(v1[2], v1[3]);
                    if (!STORE && w.x != 0x7fc1u) continue;
                    if (NT_STORES & 1) __builtin_nontemporal_store(w, (u32x4*)(rowp + bj * HALF)); else *(u32x4*)(rowp + bj * HALF) = w; } }
    }
};
using EpiProj = EpiProjT<true>;
struct EpiSwiGLU {
    static constexpr bool PERM = true, AFTER_DRAIN = false;
    bf16_t* O; const PG8_LAS float* rt; int pmA; int ldc;
    float pv[16];
    __device__ __forceinline__ void pre() const {
        int t_ = threadIdx.x; asm volatile("" : "+v"(t_));
        float q[16];
#pragma unroll
        for (int i = 0; i < 16; ++i) q[i] = pv[i];
        asm volatile("" : "+v"(q[0]), "+v"(q[1]), "+v"(q[2]), "+v"(q[3]), "+v"(q[4]), "+v"(q[5]), "+v"(q[6]), "+v"(q[7]), "+v"(q[8]), "+v"(q[9]), "+v"(q[10]), "+v"(q[11]), "+v"(q[12]), "+v"(q[13]), "+v"(q[14]), "+v"(q[15]) :: "memory");
        float s = 0.f;
#pragma unroll
        for (int i = 0; i < 16; ++i) s += q[i];
        ((PG8_LAS float*)rt)[t_] = __builtin_amdgcn_rsqf(s * (1.0f / 1024.0f) + 1e-6f);
        __syncthreads();
    }
    __device__ __forceinline__ void operator()(const f32x4 (&acc)[2][2][4][2], const Unit& u, int wr, int wc, int fr, int fq) const {
        const int row0 = u.pm * BM + wr * 64 + fr, col0 = u.pn * HALF + wc * 32 + 8 * fq; const PG8_LAS float* rtp = rt + (u.pm != pmA ? 256 : 0) + wr * 64 + fr;
        float rsv[8];
#pragma unroll
        for (int i = 0; i < 8; ++i) rsv[i] = rtp[(i >> 2) * HALF + (i & 3) * 16];
        asm volatile("" : "+v"(rsv[0]), "+v"(rsv[1]), "+v"(rsv[2]), "+v"(rsv[3]), "+v"(rsv[4]), "+v"(rsv[5]), "+v"(rsv[6]), "+v"(rsv[7]));
#pragma unroll
        for (int ai = 0; ai < 2; ++ai)
#pragma unroll
            for (int m = 0; m < 4; ++m) { const int row = row0 + ai * HALF + m * 16; const float rs = rsv[ai * 4 + m]; bf16_t* rowp = O + (size_t)row * ldc + col0;
                const float c1 = -1.4426950408889634f * rs, irs2 = __builtin_amdgcn_rcpf(rs * rs);
                u32x4 w;
                f32x2 g2[4], u2[4], t2[4];
#pragma unroll
                for (int q = 0; q < 4; ++q) { const f32x4 gq = acc[ai][0][m][q >> 1], uq = acc[ai][1][m][q >> 1]; g2[q] = (f32x2){gq[2 * (q & 1)], gq[2 * (q & 1) + 1]}; u2[q] = (f32x2){uq[2 * (q & 1)], uq[2 * (q & 1) + 1]}; }
#pragma unroll
                for (int q = 0; q < 4; ++q) t2[q] = g2[q] * c1;
#pragma unroll
                for (int q = 0; q < 4; ++q) { t2[q].x = __builtin_amdgcn_exp2f(t2[q].x); t2[q].y = __builtin_amdgcn_exp2f(t2[q].y); }
#pragma unroll
                for (int q = 0; q < 4; ++q) { t2[q] = t2[q] * irs2 + irs2; g2[q] = g2[q] * u2[q]; }
#pragma unroll
                for (int q = 0; q < 4; ++q) { t2[q].x = __builtin_amdgcn_rcpf(t2[q].x); t2[q].y = __builtin_amdgcn_rcpf(t2[q].y); }
#pragma unroll
                for (int q = 0; q < 4; ++q) { const f32x2 h2 = g2[q] * t2[q]; w[q] = cvt_pk_bf16(h2.x, h2.y); }
                if (NT_STORES & 4) __builtin_nontemporal_store(w, (u32x4*)rowp); else *(u32x4*)rowp = w; }
    }
};
template <bool BASE_F32, bool OUT_F32, bool WITH_DT> struct EpiRes {
    static constexpr bool PERM = true, AFTER_DRAIN = false;
    const void* base; void* out; float* P; const void* wdt  ; float* DTP; int ldc; int pad;
    __device__ __forceinline__ void operator()(const f32x4 (&acc)[2][2][4][2], const Unit& u, int wr, int wc, int fr, int fq) const {
        const int row0 = u.pm * BM + wr * 64 + fr, col0 = u.pn * BM + wc * 32 + 8 * fq, slot = u.pn * 4 + wc;
        bf16x8 wdf[2] = {{0, 0, 0, 0, 0, 0, 0, 0}, {0, 0, 0, 0, 0, 0, 0, 0}};
        if constexpr (WITH_DT) { if (fr < 4) { wdf[0] = *(const bf16x8*)((const bf16_t*)wdt + (size_t)fr * 1024 + col0); wdf[1] = *(const bf16x8*)((const bf16_t*)wdt + (size_t)fr * 1024 + col0 + HALF); } }
        u32x4 bh[BASE_F32 ? 1 : 2][BASE_F32 ? 1 : 4][2];
        if constexpr (!BASE_F32) {
#pragma unroll
            for (int ai = 0; ai < 2; ++ai)
#pragma unroll
                for (int m = 0; m < 4; ++m)
#pragma unroll
                    for (int bj = 0; bj < 2; ++bj) bh[ai][m][bj] = *(const u32x4*)((const bf16_t*)base + (size_t)(row0 + ai * HALF + m * 16) * ldc + col0 + bj * HALF);
            asm volatile("" ::: "memory"); }
#pragma unroll
        for (int ai = 0; ai < 2; ++ai) {
            f32x4 bf0[BASE_F32 ? 4 : 1][2], bf1[BASE_F32 ? 4 : 1][2];
            if constexpr (BASE_F32) {
#pragma unroll
                for (int m = 0; m < 4; ++m)
#pragma unroll
                    for (int bj = 0; bj < 2; ++bj) { const size_t off = (size_t)(row0 + ai * HALF + m * 16) * ldc + col0 + bj * HALF;
                        bf0[m][bj] = *(const f32x4*)((const float*)base + off); bf1[m][bj] = *(const f32x4*)((const float*)base + off + 4); }
                asm volatile("" ::: "memory"); }
#pragma unroll
            for (int m = 0; m < 4; ++m) { const int row = row0 + ai * HALF + m * 16; const size_t off = (size_t)row * ldc + col0;
                f32x4 v[2][2]; float s = 0.f;
#pragma unroll
                for (int bj = 0; bj < 2; ++bj) { f32x4 b0, b1;
                    if constexpr (BASE_F32) { b0 = bf0[m][bj]; b1 = bf1[m][bj]; }
                    else { const u32x4 r = bh[BASE_F32 ? 0 : ai][BASE_F32 ? 0 : m][bj];
                        b0 = (f32x4){__builtin_bit_cast(float, r.x << 16), __builtin_bit_cast(float, r.x & 0xffff0000u), __builtin_bit_cast(float, r.y << 16), __builtin_bit_cast(float, r.y & 0xffff0000u)};
                        b1 = (f32x4){__builtin_bit_cast(float, r.z << 16), __builtin_bit_cast(float, r.z & 0xffff0000u), __builtin_bit_cast(float, r.w << 16), __builtin_bit_cast(float, r.w & 0xffff0000u)}; }
                    v[bj][0] = acc[ai][bj][m][0] + b0; v[bj][1] = acc[ai][bj][m][1] + b1;
#pragma unroll
                    for (int n = 0; n < 2; ++n) s += (v[bj][n][0] * v[bj][n][0] + v[bj][n][1] * v[bj][n][1]) + (v[bj][n][2] * v[bj][n][2] + v[bj][n][3] * v[bj][n][3]); }
                s += lane_xor<16>(s); s = add_xor32(s);
                if (fq == 0 && !pad) P[(size_t)slot * P_STRIDE + row] = s;
                f32x4 d = {0.f, 0.f, 0.f, 0.f};
#pragma unroll
                for (int bj = 0; bj < 2; ++bj) {
                    if constexpr (OUT_F32) { *(f32x4*)((float*)out + off + bj * HALF) = v[bj][0]; *(f32x4*)((float*)out + off + bj * HALF + 4) = v[bj][1]; }
                    else { u32x4 w; w.x = cvt_pk_bf16(v[bj][0][0], v[bj][0][1]); w.y = cvt_pk_bf16(v[bj][0][2], v[bj][0][3]); w.z = cvt_pk_bf16(v[bj][1][0], v[bj][1][1]); w.w = cvt_pk_bf16(v[bj][1][2], v[bj][1][3]);
                        if (NT_STORES & 2) __builtin_nontemporal_store(w, (u32x4*)((bf16_t*)out + off + bj * HALF)); else *(u32x4*)((bf16_t*)out + off + bj * HALF) = w;
                        if constexpr (WITH_DT) d = __builtin_amdgcn_mfma_f32_16x16x32_bf16(wdf[bj], __builtin_bit_cast(bf16x8, w), d, 0, 0, 0); } }
                if constexpr (WITH_DT) { if (fq == 0) *(f32x4*)(DTP + ((size_t)slot * P_STRIDE + row) * 4) = d; } } }
    }
};

struct EpiResFinal {
    static constexpr bool PERM = true, AFTER_DRAIN = false;
    const bf16_t* base; float* out; unsigned* P; unsigned* cnt; const float* g; unsigned* tmo; int ldc; int panel0;
    __device__ __forceinline__ void operator()(const f32x4 (&acc_)[2][2][4][2], const Unit& u, int wr, int wc, int fr, int fq) const {
        f32x4 (&acc)[2][2][4][2] = const_cast<f32x4 (&)[2][2][4][2]>(acc_);
        const int row0 = u.pm * BM + wr * 64 + fr, col0 = u.pn * BM + wc * 32 + 8 * fq, slot = u.pn * 4 + wc;
#pragma unroll
        for (int ai = 0; ai < 2; ++ai) { u32x4 bh[4][2];
#pragma unroll
            for (int m = 0; m < 4; ++m)
#pragma unroll
                for (int bj = 0; bj < 2; ++bj) bh[m][bj] = *(const u32x4*)(base + (size_t)(row0 + ai * HALF + m * 16) * ldc + col0 + bj * HALF);
            asm volatile("" ::: "memory");
#pragma unroll
            for (int m = 0; m < 4; ++m) { const int row = row0 + ai * HALF + m * 16; float s = 0.f;
#pragma unroll
                for (int bj = 0; bj < 2; ++bj) { const u32x4 r = bh[m][bj];
                    const f32x4 b0 = {__builtin_bit_cast(float, r.x << 16), __builtin_bit_cast(float, r.x & 0xffff0000u), __builtin_bit_cast(float, r.y << 16), __builtin_bit_cast(float, r.y & 0xffff0000u)};
                    const f32x4 b1 = {__builtin_bit_cast(float, r.z << 16), __builtin_bit_cast(float, r.z & 0xffff0000u), __builtin_bit_cast(float, r.w << 16), __builtin_bit_cast(float, r.w & 0xffff0000u)};
                    acc[ai][bj][m][0] += b0; acc[ai][bj][m][1] += b1;
#pragma unroll
                    for (int n = 0; n < 2; ++n) { const f32x4 v = acc[ai][bj][m][n]; s += (v[0] * v[0] + v[1] * v[1]) + (v[2] * v[2] + v[3] * v[3]); } }
                s += lane_xor<16>(s); s = add_xor32(s);
                if (fq == 0) __hip_atomic_store(P + (size_t)slot * P_STRIDE + row, __builtin_bit_cast(unsigned, s), __ATOMIC_RELAXED, __HIP_MEMORY_SCOPE_AGENT); } }
        asm volatile("s_waitcnt vmcnt(0)" ::: "memory");
        unsigned* cw = cnt + 64 * (panel0 + u.pm);
        if (fr == 0 && fq == 0) (void)__hip_atomic_fetch_add(cw, 1u, __ATOMIC_RELAXED, __HIP_MEMORY_SCOPE_AGENT);
        { unsigned spins = 0;
          while ((unsigned)__builtin_amdgcn_readfirstlane((int)__hip_atomic_load(cw, __ATOMIC_RELAXED, __HIP_MEMORY_SCOPE_AGENT)) < 32u) {
              __builtin_amdgcn_s_sleep(1);
              if (++spins > (1u << 22)) { if (fr == 0 && fq == 0) __hip_atomic_store(tmo, 1u, __ATOMIC_RELAXED, __HIP_MEMORY_SCOPE_AGENT); break; } } }
        f32x4 gv[2][2];
#pragma unroll
        for (int bj = 0; bj < 2; ++bj) { gv[bj][0] = *(const f32x4*)(g + col0 + bj * HALF); gv[bj][1] = *(const f32x4*)(g + col0 + bj * HALF + 4); }
#pragma unroll
        for (int ai = 0; ai < 2; ++ai)
#pragma unroll
            for (int m = 0; m < 4; ++m) { const int row = row0 + ai * HALF + m * 16; float s = 0.f;
#pragma unroll
                for (int j = 0; j < 4; ++j) s += __builtin_bit_cast(float, __hip_atomic_load(P + (size_t)(4 * fq + j) * P_STRIDE + row, __ATOMIC_RELAXED, __HIP_MEMORY_SCOPE_AGENT));
                s += lane_xor<16>(s); s = add_xor32(s);
                const float rs = 1.0f / __builtin_sqrtf(s * (1.0f / 1024.0f) + 1e-6f);
                float* orow = out + (size_t)row * ldc + col0;
#pragma unroll
                for (int bj = 0; bj < 2; ++bj) { *(f32x4*)(orow + bj * HALF) = acc[ai][bj][m][0] * rs * gv[bj][0]; *(f32x4*)(orow + bj * HALF + 4) = acc[ai][bj][m][1] * rs * gv[bj][1]; } }
    }
};

struct EpiNull {
    static constexpr bool PERM = true, AFTER_DRAIN = false;
    __device__ __forceinline__ void operator()(const f32x4 (&acc)[2][2][4][2], const Unit&, int, int, int, int) const {
#pragma unroll
        for (int a = 0; a < 2; ++a)
#pragma unroll
            for (int b = 0; b < 2; ++b)
#pragma unroll
                for (int m = 0; m < 4; ++m)
#pragma unroll
                    for (int n = 0; n < 2; ++n) asm volatile("" :: "v"(acc[a][b][m][n]));
    }
};
struct FixedOrder {
    int n;
    __device__ bool next(int i, Unit& u) const { if (i >= n) return false; u.pm = 0; u.pn = 0; return true; }
    __device__ __forceinline__ void a_ready(const Unit&) const {}
    __device__ __forceinline__ void done(const Unit&) const {}
};
template <class T, class = void> struct HasPre { static constexpr bool v = false; };
template <class T> struct HasPre<T, decltype((void)&T::pre)> { static constexpr bool v = true; };
template <class Epi, class Sched, bool ALIGN_EPI = false, bool SP2 = false>
__device__ __forceinline__ void gemm_phase(PG8_LAS unsigned char* lds, const Gemm g, const Sched& S, const Epi& E) {
    int tid_ = threadIdx.x; asm volatile("" : "+v"(tid_));
    const int tid = tid_, wid = __builtin_amdgcn_readfirstlane(tid >> 6), lane = tid & 63, wr = wid >> 2, wc = wid & 3, fr = lane & 15, fq = lane >> 4;
    const int K = g.K, nt = K / BK;
    unsigned voffA[2], voffB[2];
#pragma unroll
    for (int i = 0; i < 2; ++i) { int R, C; stage_rc(tid * 16 + i * 8192, R, C); const int Rb = Epi::PERM ? ((R & ~31) + perm32(R & 31)) : R;
        voffA[i] = (unsigned)(R * K + C) * 2u; voffB[i] = (unsigned)(Rb * K + C) * 2u; }
    const size_t kstep = (size_t)(BK * 2);
    const size_t hstep = (size_t)HALF * K * 2;
    const size_t tstep = 2 * hstep;
    const unsigned ldsw = (unsigned)wid * 1024u;
    const int aoff = lds_byte(wr * 64 + fr, fq * 8), boff = lds_byte(wc * 32 + fr, fq * 8);
#define PG8_SA(b, h) (((b) * 2 + (h)) * HTB)
#define PG8_SB(b, h) ((4 + (b) * 2 + (h)) * HTB)
#define PG8_STAGE(bufoff, gbase, voff) do { _Pragma("unroll") for (int _i = 0; _i < 2; ++_i) \
        __builtin_amdgcn_global_load_lds((const unsigned*)((const char*)(gbase) + (voff)[_i]), (PG8_LAS unsigned*)(lds + (bufoff) + ldsw + _i * 8192), 16, 0, 0); } while (0)
#define PG8_LDA(dst, b, h) do { _Pragma("unroll") for (int m = 0; m < 4; ++m) _Pragma("unroll") for (int k = 0; k < 2; ++k) dst[m][k] = *(const PG8_LAS bf16x8*)(lds + PG8_SA(b, h) + aoff + m * 2048 + k * 1024); } while (0)
#define PG8_LDB(dst, b, h) do { _Pragma("unroll") for (int n = 0; n < 2; ++n) _Pragma("unroll") for (int k = 0; k < 2; ++k) dst[n][k] = *(const PG8_LAS bf16x8*)(lds + PG8_SB(b, h) + boff + n * 2048 + k * 1024); } while (0)
#define PG8_MMA(ai, bj, At, Bt) do { __builtin_amdgcn_s_setprio(1); _Pragma("unroll") for (int m = 0; m < 4; ++m) _Pragma("unroll") for (int n = 0; n < 2; ++n) _Pragma("unroll") for (int k = 0; k < 2; ++k) \
        acc[ai][bj][m][n] = __builtin_amdgcn_mfma_f32_16x16x32_bf16(Bt[n][k], At[m][k], acc[ai][bj][m][n], 0, 0, 0); __builtin_amdgcn_s_setprio(0); } while (0)
#define PG8_WAIT_V(n) asm volatile("s_waitcnt vmcnt(" #n ")" ::: "memory")
#define PG8_WAIT_L(n) asm volatile("s_waitcnt lgkmcnt(" #n ")" ::: "memory")
#define PG8_BAR __builtin_amdgcn_s_barrier()
#define PG8_SCHED __builtin_amdgcn_sched_barrier(0)
    Unit cur, nxt; int ui = 0;
    if (!S.next(0, cur)) return;
    f32x4 acc[2][2][4][2];
#pragma unroll
    for (int a = 0; a < 2; ++a)
#pragma unroll
        for (int b = 0; b < 2; ++b)
#pragma unroll
            for (int m = 0; m < 4; ++m)
#pragma unroll
                for (int n = 0; n < 2; ++n) acc[a][b][m][n] = (f32x4){0.f, 0.f, 0.f, 0.f};
    bf16x8 At[4][2], B0[2][2], B1[2][2];
    const char* cA = (const char*)g.A + (size_t)cur.pm * tstep; const char* cB = (const char*)g.Bt + (size_t)cur.pn * tstep;
    S.a_ready(cur);
    if constexpr (SP2) {
        PG8_STAGE(PG8_SB(0, 0), cB, voffB); PG8_STAGE(PG8_SB(0, 1), cB + hstep, voffB); PG8_STAGE(PG8_SA(0, 0), cA, voffA); PG8_STAGE(PG8_SA(0, 1), cA + hstep, voffA);
        PG8_STAGE(PG8_SB(1, 0), cB + kstep, voffB); PG8_STAGE(PG8_SA(1, 0), cA + kstep, voffA); PG8_STAGE(PG8_SB(1, 1), cB + hstep + kstep, voffB);
        if constexpr (HasPre<Epi>::v) E.pre();
        if (wr == 1) PG8_BAR;
        PG8_WAIT_V(8); PG8_BAR;
        PG8_WAIT_V(6); PG8_BAR;
    } else {
        PG8_STAGE(PG8_SB(0, 0), cB, voffB); PG8_STAGE(PG8_SA(0, 0), cA, voffA); PG8_STAGE(PG8_SB(0, 1), cB + hstep, voffB); PG8_STAGE(PG8_SA(0, 1), cA + hstep, voffA);
        if (wr == 1) PG8_BAR;
        PG8_WAIT_V(4); PG8_BAR;
        PG8_STAGE(PG8_SB(1, 0), cB + kstep, voffB); PG8_STAGE(PG8_SA(1, 0), cA + kstep, voffA); PG8_STAGE(PG8_SB(1, 1), cB + hstep + kstep, voffB);
        PG8_WAIT_V(6); PG8_BAR;
    }
    for (;;) {
        const bool has_next = S.next(ui + 1, nxt);
        const char* nA = has_next ? (const char*)g.A + (size_t)nxt.pm * tstep : cA; const char* nB = has_next ? (const char*)g.Bt + (size_t)nxt.pn * tstep : cB;
        for (int t = 0; t < nt; t += 2) {
            const bool last = (t == nt - 2);
            const char* a1 = cA + (size_t)(t + 1) * kstep;
            const char* a2 = last ? nA : cA + (size_t)(t + 2) * kstep; const char* b2 = last ? nB : cB + (size_t)(t + 2) * kstep;
            const char* a3 = a2 + kstep; const char* b3 = b2 + kstep;
            if (last && has_next) S.a_ready(nxt);
            if constexpr (SP2) {
            PG8_LDB(B0, 0, 0); PG8_LDB(B1, 0, 1); PG8_SCHED; PG8_LDA(At, 0, 0); PG8_STAGE(PG8_SA(1, 1), a1 + hstep, voffA);
            PG8_WAIT_V(8); PG8_WAIT_L(0); PG8_BAR; PG8_MMA(0, 0, At, B0); PG8_MMA(0, 1, At, B1); PG8_BAR; PG8_SCHED;
            PG8_LDA(At, 0, 1); PG8_STAGE(PG8_SB(0, 0), b2, voffB); PG8_STAGE(PG8_SB(0, 1), b2 + hstep, voffB); PG8_STAGE(PG8_SA(0, 0), a2, voffA);
            PG8_WAIT_V(8); PG8_WAIT_L(0); PG8_BAR; PG8_MMA(1, 0, At, B0); PG8_MMA(1, 1, At, B1); PG8_BAR; PG8_SCHED;
            PG8_LDB(B0, 1, 0); PG8_LDB(B1, 1, 1); PG8_SCHED; PG8_LDA(At, 1, 0); PG8_STAGE(PG8_SA(0, 1), a2 + hstep, voffA);
            PG8_WAIT_V(8); PG8_WAIT_L(0); PG8_BAR; PG8_MMA(0, 0, At, B0); PG8_MMA(0, 1, At, B1); PG8_BAR; PG8_SCHED;
            PG8_LDA(At, 1, 1); PG8_STAGE(PG8_SB(1, 0), b3, voffB); PG8_STAGE(PG8_SB(1, 1), b3 + hstep, voffB); PG8_STAGE(PG8_SA(1, 0), a3, voffA);
            PG8_WAIT_V(8); PG8_WAIT_L(0); PG8_BAR; PG8_MMA(1, 0, At, B0); PG8_MMA(1, 1, At, B1); PG8_BAR; PG8_SCHED;
            } else {
            PG8_LDB(B0, 0, 0); PG8_SCHED; PG8_LDA(At, 0, 0); PG8_STAGE(PG8_SA(1, 1), a1 + hstep, voffA);
            PG8_WAIT_L(8); PG8_BAR; PG8_WAIT_L(0); PG8_MMA(0, 0, At, B0); PG8_BAR; PG8_SCHED;
            PG8_LDB(B1, 0, 1); PG8_STAGE(PG8_SB(0, 0), b2, voffB);
            PG8_BAR; PG8_WAIT_L(0); PG8_MMA(0, 1, At, B1); PG8_BAR;
            PG8_LDA(At, 0, 1); PG8_STAGE(PG8_SA(0, 0), a2, voffA);
            PG8_BAR; PG8_WAIT_L(0); PG8_MMA(1, 0, At, B0); PG8_BAR; PG8_SCHED;
            PG8_STAGE(PG8_SB(0, 1), b2 + hstep, voffB);
            PG8_WAIT_V(6); PG8_BAR; PG8_MMA(1, 1, At, B1); PG8_BAR;
            PG8_LDB(B0, 1, 0); PG8_SCHED; PG8_LDA(At, 1, 0); PG8_STAGE(PG8_SA(0, 1), a2 + hstep, voffA);
            PG8_WAIT_L(8); PG8_BAR; PG8_WAIT_L(0); PG8_MMA(0, 0, At, B0); PG8_BAR; PG8_SCHED;
            PG8_LDB(B1, 1, 1); PG8_STAGE(PG8_SB(1, 0), b3, voffB);
            PG8_BAR; PG8_WAIT_L(0); PG8_MMA(0, 1, At, B1); PG8_BAR;
            PG8_LDA(At, 1, 1); PG8_STAGE(PG8_SA(1, 0), a3, voffA);
            PG8_BAR; PG8_WAIT_L(0); PG8_MMA(1, 0, At, B0); PG8_BAR; PG8_SCHED;
            PG8_STAGE(PG8_SB(1, 1), b3 + hstep, voffB);
            PG8_WAIT_V(6); PG8_BAR; PG8_MMA(1, 1, At, B1); PG8_BAR;
            }
        }
        if constexpr (ALIGN_EPI) { if (wr == 0) PG8_BAR; }
        if constexpr (!Epi::AFTER_DRAIN) { E(acc, cur, wr, wc, fr, fq); S.done(cur); }
        if (!has_next) break;
#pragma unroll
        for (int a = 0; a < 2; ++a)
#pragma unroll
            for (int b = 0; b < 2; ++b)
#pragma unroll
                for (int m = 0; m < 4; ++m)
#pragma unroll
                    for (int n = 0; n < 2; ++n) acc[a][b][m][n] = (f32x4){0.f, 0.f, 0.f, 0.f};
        cur = nxt; cA = nA; cB = nB; ++ui;
        if constexpr (ALIGN_EPI) { if (wr == 1) PG8_BAR; }
    }
    PG8_WAIT_V(0);
    if constexpr (!ALIGN_EPI) { if (wr == 0) PG8_BAR; }
    PG8_BAR;
    if constexpr (Epi::AFTER_DRAIN) { E.fused(acc, cur, wr, wc, fr, fq, lds, wid, lane); S.done(cur); }
#undef PG8_SA
#undef PG8_SB
#undef PG8_STAGE
#undef PG8_LDA
#undef PG8_LDB
#undef PG8_MMA
#undef PG8_WAIT_V
#undef PG8_WAIT_L
#undef PG8_BAR
#undef PG8_SCHED
}
}
#define GAS __attribute__((address_space(1)))
#define LAS __attribute__((address_space(3)))
typedef unsigned short bf16;
typedef unsigned v4u __attribute__((ext_vector_type(4)));
typedef float f32x4 __attribute__((ext_vector_type(4)));
typedef short bf16x8 __attribute__((ext_vector_type(8)));
typedef GAS unsigned gu32;
typedef GAS unsigned long long gu64;
#define RLX_AGENT __ATOMIC_RELAXED, __HIP_MEMORY_SCOPE_AGENT
#define LDS_WAIT() asm volatile("s_waitcnt lgkmcnt(0)" ::: "memory")
#define VM_WAIT() asm volatile("s_waitcnt vmcnt(0)" ::: "memory")
__device__ __forceinline__ unsigned long long rt() { return __builtin_amdgcn_s_memrealtime(); }
__device__ __forceinline__ unsigned f2bf(float f) { unsigned u = __builtin_bit_cast(unsigned, f); return (u + 0x7fffu + ((u >> 16) & 1u)) >> 16; }
typedef float f32x2_t __attribute__((ext_vector_type(2)));
typedef __bf16 bf16x2_t __attribute__((ext_vector_type(2)));
__device__ __forceinline__ unsigned pk2(float lo, float hi) { return __builtin_bit_cast(unsigned, __builtin_convertvector((f32x2_t){lo, hi}, bf16x2_t)); }
#define XB_TMO      128
#define XB_XCNT(j)  (256  + 64 * (j))
#define XB_XSUB(j)  (1280 + 64 * (j))
#define XB_XGEN(j)  (2304 + 64 * (j))
#define XB_TOP      3328
#define XB_TOPGEN   3392
#define XCD_BAR_WORDS 3456
#define XB_SPIN_CAP (1u << 18)

__device__ __forceinline__ unsigned xb_ld(unsigned* p)              { return __hip_atomic_load(p, __ATOMIC_RELAXED, __HIP_MEMORY_SCOPE_AGENT); }
__device__ __forceinline__ unsigned xb_add(unsigned* p, unsigned v) { return __hip_atomic_fetch_add(p, v, __ATOMIC_RELAXED, __HIP_MEMORY_SCOPE_AGENT); }
__device__ __forceinline__ unsigned xb_xcc_id() { return (unsigned)__builtin_amdgcn_s_getreg((3 << 11) | 20) & 0xFu; }
#define XB_SPIN(cond, bar) do { unsigned _sp = 0; while (cond) { __builtin_amdgcn_s_sleep(1); \
    if ((++_sp & 255u) == 0u) { if (xb_ld(&(bar)[XB_TMO])) break; if (_sp > XB_SPIN_CAP) { atomicAdd(&(bar)[XB_TMO], 1u); break; } } } } while (0)

struct XcdBarrier {
    unsigned* bar; unsigned x;
    volatile LAS unsigned* st;
    unsigned G;
};

__device__ __forceinline__ XcdBarrier xcd_barrier_post(unsigned* bar, volatile LAS unsigned* st) {
    XcdBarrier b; b.bar = bar; b.x = xb_xcc_id(); b.st = st; b.G = 0u;
    if (threadIdx.x == 0) (void)xb_add(&bar[XB_XCNT(b.x)], 1u);
    return b;
}
__device__ __forceinline__ void xcd_barrier_complete(unsigned* bar, unsigned x, unsigned G, unsigned& nloc, unsigned& nx) {
    unsigned sum, cnt, mine, sp = 0u;
    for (;;) {
        sum = 0u; cnt = 0u; mine = 0u;
#pragma unroll
        for (unsigned j = 0; j < 16; ++j) { const unsigned c = xb_ld(&bar[XB_XCNT(j)]); sum += c; cnt += (c > 0u) ? 1u : 0u; mine = (j == x) ? c : mine; }
        if (sum == G) break;
        __builtin_amdgcn_s_sleep(1);
        if ((++sp & 255u) == 0u) { if (xb_ld(&bar[XB_TMO])) break; if (sp > XB_SPIN_CAP) { atomicAdd(&bar[XB_TMO], 1u); break; } }
    }
    nloc = mine > 0u ? mine : 1u; nx = cnt > 0u ? cnt : 1u;
}

__device__ __forceinline__ void xcd_barrier(const XcdBarrier& b) {
    asm volatile("s_waitcnt vmcnt(0)" ::: "memory");
    __syncthreads();
    if (threadIdx.x == 0) {
        unsigned* bar = b.bar;
        __builtin_amdgcn_s_waitcnt(0);
        unsigned nloc = b.st[0], nx = b.st[1];
        if (nloc == 0u) { xcd_barrier_complete(bar, b.x, b.G, nloc, nx); b.st[0] = nloc; b.st[1] = nx; }
        const unsigned old = xb_add(&bar[XB_XSUB(b.x)], 1u);
        const unsigned gen = old / nloc;
        if (old + 1u == (gen + 1u) * nloc) {
            if (nx > 1u)
            __builtin_amdgcn_fence(__ATOMIC_RELEASE, "agent");
            asm volatile("s_waitcnt vmcnt(0)" ::: "memory");
            if (nx > 1u) {
            const unsigned og = xb_add(&bar[XB_TOP], 1u);
            const unsigned tg = og / nx;
            if (og + 1u == (tg + 1u) * nx) xb_add(&bar[XB_TOPGEN], 1u);
            else XB_SPIN(xb_ld(&bar[XB_TOPGEN]) == tg, bar);
            }
            __builtin_amdgcn_fence(__ATOMIC_ACQUIRE, "agent");
            xb_add(&bar[XB_XGEN(b.x)], 1u);
            asm volatile("s_waitcnt vmcnt(0)" ::: "memory");
        } else {
            XB_SPIN(xb_ld(&bar[XB_XGEN(b.x)]) == gen, bar);
            __builtin_amdgcn_fence(__ATOMIC_ACQUIRE, "agent");
            asm volatile("s_waitcnt vmcnt(0)" ::: "memory");
        }
    }
    __syncthreads();
}
constexpr int DM = 1024, NB = 16, SEQ = 2048, M = NB * SEQ, DEPTH = 2;
constexpr int NPROJ = 2560, INCOLS = 2564, DFF = 2816, NGU = 2 * DFF;
constexpr float EPS = 1e-6f;
constexpr size_t MiB = 1u << 20;
constexpr size_t WS_CTL = 0, CTL_ZERO_BYTES = 1 * MiB;
constexpr size_t WS_WIN = 2 * MiB, WS_WOUT = 12 * MiB, WS_WGU = 16 * MiB, WS_WDN = 38 * MiB;
constexpr size_t WS_DT = 49 * MiB, WS_PW = 50 * MiB, WS_SW = 51 * MiB, WS_DEC = 52 * MiB, WS_WDT = 53 * MiB;
constexpr size_t WS_HB = 64 * MiB;
constexpr size_t WS_ACT = 128 * MiB;
constexpr size_t WS_ST = 352 * MiB, WS_PV = 416 * MiB;
constexpr size_t WS_SSQ = 448 * MiB, WS_DTP = 460 * MiB, WS_END = 468 * MiB;
#ifndef NGROUPS
#define NGROUPS 8
#endif
#ifndef SKEW_US
#define SKEW_US 0
#endif
#ifndef STAG_G1
#define STAG_G1 0
#endif
#ifndef STAG_G3
#define STAG_G3 0
#endif
constexpr int MG = M / NGROUPS;
constexpr size_t ACT_GROUP_BYTES = (size_t)MG * (NPROJ + DM) * 2;
static_assert((size_t)MG * DFF * 2 <= ACT_GROUP_BYTES && WS_ACT + NGROUPS * ACT_GROUP_BYTES <= WS_ST, "activation blocks");
static_assert(P_STRIDE == M, "P_STRIDE");
constexpr int NWAVES = 8;
constexpr int RING_BYTES = 131072, LDS_BYTES = 163840, LDSCTL_OFF = LDS_BYTES - 512, MISC_OFF = LDSCTL_OFF + 320;
constexpr int CW_BAR = 4096;
constexpr int CW_FIN = 131072;
#ifndef FUSE_FINAL
#define FUSE_FINAL 1
#endif
constexpr int RT_OFF = RING_BYTES + 64;
#ifndef REP_M1
#define REP_M1 1
#endif
#ifndef REP_POOL
#define REP_POOL 1
#endif
#ifndef REP_SGU
#define REP_SGU 1
#endif
#ifndef REP_SCONV
#define REP_SCONV 1
#endif
#ifndef REP_SCAN
#define REP_SCAN 1
#endif
#ifndef REP_SSDOUT
#define REP_SSDOUT 1
#endif
#ifndef REP_G1
#define REP_G1 1
#endif
#ifndef REP_G3
#define REP_G3 1
#endif
#ifndef REP_BAR
#define REP_BAR 1
#endif
#ifndef PROBE_G2
#define PROBE_G2 0
#endif
#ifndef PROBE_G4
#define PROBE_G4 0
#endif
#ifndef REP_P0
#define REP_P0 1
#endif
#ifndef REP_XPASS
#define REP_XPASS 1
#endif
#ifndef TSLOT
#define TSLOT -1
#endif
#ifndef TQUANT
#define TQUANT 0
#endif
#ifndef PROBE_KLOOP
#define PROBE_KLOOP 0
#endif
#ifndef CQ
#define CQ 50ull
#endif
#ifndef SSD_SKIP
#define SSD_SKIP 0
#endif
#ifndef GEMM_ALIGN
#define GEMM_ALIGN true
#endif
#ifndef GEMM_SP2
#define GEMM_SP2 true
#endif
#ifndef G2_NULL
#define G2_NULL 0
#endif
#ifndef GROUP_SPREAD
#define GROUP_SPREAD 0
#endif
#ifndef PROBE_NOP
#define PROBE_NOP 0
#endif
__device__ __forceinline__ float bf2f(bf16 u) { return __builtin_bit_cast(float, (unsigned)u << 16); }
__device__ __forceinline__ float wave_sum(float v) {
    v += dpp_f<0xB1>(v); v += dpp_f<0x4E>(v); v += dpp_f<0x141>(v); v += dpp_f<0x140>(v); v += lane_xor<16>(v); v = add_xor32(v);
    return v;
}
__device__ __forceinline__ float fexp(float x) { return __builtin_amdgcn_exp2f(x * 1.4426950408889634f); }
__device__ __forceinline__ float frsq(float x) { return __builtin_amdgcn_rsqf(x); }
__device__ __forceinline__ float frcp(float x) { return __builtin_amdgcn_rcpf(x); }

__device__ __forceinline__ int fresh_tid() { int t = threadIdx.x; asm volatile("" : "+v"(t)); return t; }
struct Args { const float* in[23]; float* out; unsigned char* ws; };
struct Frame { LAS unsigned char* lds; volatile LAS unsigned* MISC; gu32* ctl; int wave;
               int bid, vcu, G;
               int gbid, gvcu, GG; };

__device__ __forceinline__ void p_transpose(Frame& F, const float* W, int K, int ldn, int nblk, bf16* WT, int mode, const float* gk) {
    LAS float* scr = (LAS float*)(F.lds + F.wave * 16384);
    const int gw = F.gvcu * NWAVES + F.wave, NGW = F.GG * NWAVES, lane = fresh_tid() & 63;
    const int nitems = (K / 64) * nblk;
    for (int item = gw; item < nitems; item += NGW) {
        const int kb = item / nblk, nb = item % nblk, k0 = 64 * kb, n0 = 32 * nb;
        const float* src = W + (size_t)(k0 + (lane >> 5)) * ldn + n0 + (lane & 31);
        float r[32];
#pragma unroll
        for (int i = 0; i < 32; ++i) r[i] = src[(size_t)(2 * i) * ldn];
        const int c = lane & 7;
        f32x4 g0 = {1.f, 1.f, 1.f, 1.f}, g1 = {1.f, 1.f, 1.f, 1.f};
        if (gk) { g0 = *(const GAS f32x4*)(gk + k0 + 8 * c); g1 = *(const GAS f32x4*)(gk + k0 + 8 * c + 4); }
#pragma unroll
        for (int i = 0; i < 32; ++i) scr[(2 * i + (lane >> 5)) * 33 + (lane & 31)] = r[i];
        LDS_WAIT(); asm volatile("" ::: "memory");
#pragma unroll
        for (int j = 0; j < 4; ++j) { const int n = (lane >> 3) + 8 * j; const LAS float* s = scr + (8 * c) * 33 + n;
            v4u o; o.x = pk2(s[0 * 33] * g0.x, s[1 * 33] * g0.y); o.y = pk2(s[2 * 33] * g0.z, s[3 * 33] * g0.w); o.z = pk2(s[4 * 33] * g1.x, s[5 * 33] * g1.y); o.w = pk2(s[6 * 33] * g1.z, s[7 * 33] * g1.w);
            const int ng = n0 + n; const int drow = (mode == 0) ? ng : (((ng >> 7) << 8) + (mode == 2 ? 128 : 0) + (ng & 127));
            *(GAS v4u*)(WT + (size_t)drow * K + k0 + 8 * c) = o; }
        LDS_WAIT(); asm volatile("" ::: "memory");
    }
}
__device__ __forceinline__ void p_xpass(Frame& F, const float* x, const float* g, const float* wdt, bf16* hb, float* P, float* dt) {
    const int lane = fresh_tid() & 63;
    const int gw = F.vcu * NWAVES + F.wave, NGW = F.G * NWAVES;
    LAS f32x4* wl = (LAS f32x4*)F.lds;
    __syncthreads();
    for (int i = fresh_tid(); i < DM; i += NWAVES * 64) wl[i] = *(const GAS f32x4*)(wdt + (size_t)i * INCOLS) * g[i];
    __syncthreads();
    for (int row = gw; row < MG; row += NGW) {
        const GAS f32x4* hr = (const GAS f32x4*)(x + (size_t)row * DM) + lane;
        f32x4 v[4]; float s = 0.f;
#pragma unroll
        for (int j = 0; j < 4; ++j) { v[j] = hr[64 * j]; s += (v[j].x * v[j].x + v[j].y * v[j].y) + (v[j].z * v[j].z + v[j].w * v[j].w); }
        s = wave_sum(s);
        const float rstd = frsq(s * (1.0f / DM) + EPS);
        GAS unsigned long long* o8 = (GAS unsigned long long*)(hb + (size_t)row * DM) + lane;
        f32x4 d = {0.f, 0.f, 0.f, 0.f};
#pragma unroll
        for (int j = 0; j < 4; ++j) { const f32x4 y = v[j];
            o8[64 * j] = (unsigned long long)pk2(y.x, y.y) | ((unsigned long long)pk2(y.z, y.w) << 32);
            const int k = 4 * (lane + 64 * j);
#pragma unroll
            for (int e = 0; e < 4; ++e) d += y[e] * wl[k + e]; }
        d.x = wave_sum(d.x); d.y = wave_sum(d.y); d.z = wave_sum(d.z); d.w = wave_sum(d.w);
        if (lane == 0) *(GAS f32x4*)(dt + (size_t)row * 4) = d * rstd;
        if (lane < 16) P[(size_t)lane * P_STRIDE + row] = s * (1.0f / 16.0f);
    }
    __syncthreads();
}

typedef unsigned u32x2 __attribute__((ext_vector_type(2)));
__device__ __forceinline__ f32x4 mfma16(bf16x8 first, bf16x8 second, f32x4 c) { return __builtin_amdgcn_mfma_f32_16x16x32_bf16(first, second, c, 0, 0, 0); }
__device__ __forceinline__ float bfe(bf16x8 v, int e) { return __builtin_bit_cast(float, (unsigned)(unsigned short)v[e] << 16); }
__device__ __forceinline__ bf16x8 pack8(const float (&f)[8]) { v4u o; o.x = pk2(f[0], f[1]); o.y = pk2(f[2], f[3]); o.z = pk2(f[4], f[5]); o.w = pk2(f[6], f[7]); return __builtin_bit_cast(bf16x8, o); }
__device__ __forceinline__ u32x2 pack4(f32x4 f) { u32x2 o; o.x = pk2(f.x, f.y); o.y = pk2(f.z, f.w); return o; }
__device__ __forceinline__ f32x4 unpack4(u32x2 u) { f32x4 f; f.x = __builtin_bit_cast(float, u.x << 16); f.y = __builtin_bit_cast(float, u.x & 0xffff0000u); f.z = __builtin_bit_cast(float, u.y << 16); f.w = __builtin_bit_cast(float, u.y & 0xffff0000u); return f; }
__device__ __forceinline__ float silu_fast(float x) { return x * __builtin_amdgcn_rcpf(1.0f + __builtin_amdgcn_exp2f(-1.4426950408889634f * x)); }
__device__ __forceinline__ float softplus_f(float x) { const float e = fexp(x); const float s = e * (1.0f - e * (0.5f - e * (0.33333334f - 0.25f * e))); const float b = __builtin_amdgcn_logf(1.0f + e) * 0.6931471805599453f; return x > 20.f ? x : (e < 0.03f ? s : b); }

__device__ __forceinline__ void p_finalnorm(Frame& F, const bf16* hb, float* out, const float* P, const float* g) {
    const int lane = fresh_tid() & 63;
    const int gw = F.vcu * NWAVES + F.wave, NGW = F.G * NWAVES;
    const GAS f32x4* gr = (const GAS f32x4*)g + 2 * lane;
    const f32x4 g0 = gr[0], g1 = gr[1], g2 = gr[128], g3 = gr[129];
    for (int row0 = 4 * gw; row0 < MG; row0 += 4 * NGW) {
        float s = P[(size_t)(lane & 15) * P_STRIDE + row0 + (lane >> 4)];
        v4u a[4], b[4];
#pragma unroll
        for (int r = 0; r < 4; ++r) { a[r] = *(const GAS v4u*)(hb + (size_t)(row0 + r) * DM + 8 * lane); b[r] = *(const GAS v4u*)(hb + (size_t)(row0 + r) * DM + 512 + 8 * lane); }
        s += lane_xor<1>(s); s += lane_xor<2>(s); s += lane_xor<4>(s); s += lane_xor<8>(s);
        const float rsl = frsq(s * (1.0f / DM) + EPS);
#pragma unroll
        for (int r = 0; r < 4; ++r) { const float rstd = __builtin_bit_cast(float, __builtin_amdgcn_readlane(__builtin_bit_cast(int, rsl), 16 * r));
            GAS f32x4* o = (GAS f32x4*)(out + (size_t)(row0 + r) * DM) + 2 * lane;
            o[0] = unpack4((u32x2){a[r].x, a[r].y}) * rstd * g0; o[1] = unpack4((u32x2){a[r].z, a[r].w}) * rstd * g1;
            o[128] = unpack4((u32x2){b[r].x, b[r].y}) * rstd * g2; o[129] = unpack4((u32x2){b[r].z, b[r].w}) * rstd * g3; }
    }
}

__device__ __forceinline__ void p_small_weights(Frame& F, const float* pw, bf16* pwT, const float* sw, bf16* swm) {
    const int tid = fresh_tid();
    for (int idx = F.gbid * 512 + tid; idx < 4 * 64 * 64; idx += F.GG * 512) { const int g = idx >> 12, d = (idx >> 6) & 63, c = idx & 63; pwT[idx] = (bf16)f2bf(pw[(g * 64 + c) * 64 + d]); }
    for (int idx = F.gbid * 512 + tid; idx < 4 * 128 * 128; idx += F.GG * 512) { const int i = (idx >> 7) & 127, j = idx & 127; swm[idx] = (i < 64 && j >= 64) ? (bf16)0 : (bf16)f2bf(sw[idx]); }
}

__device__ __forceinline__ bf16x8 row_or_zero(const bf16* p, int trel) {
    const int fix = trel < 0 ? -trel : 0; const v4u v = *(const GAS v4u*)(p + (ptrdiff_t)fix * NPROJ); const unsigned m = trel < 0 ? 0u : 0xffffffffu;
    return __builtin_bit_cast(bf16x8, (v4u){v.x & m, v.y & m, v.z & m, v.w & m});
}
__device__ __forceinline__ int prow32(int nt, int fr) { return 32 * (nt >> 1) + 8 * (fr >> 2) + 4 * (nt & 1) + (fr & 3); }
__device__ __forceinline__ bf16x8 pack8v(f32x4 a, f32x4 b) { v4u o; o.x = pk2(a.x, a.y); o.y = pk2(a.z, a.w); o.z = pk2(b.x, b.y); o.w = pk2(b.z, b.w); return __builtin_bit_cast(bf16x8, o); }
template <int WIN> __device__ __forceinline__ void pool_run(const bf16* col, int ts0, LAS bf16* dst, int ldp) {
    bf16x8 R[WIN + 7];
#pragma unroll
    for (int j = 0; j < WIN + 7; ++j) R[j] = row_or_zero(col + (ptrdiff_t)(j - (WIN - 1)) * NPROJ, ts0 + j - (WIN - 1));
    float s[8];
#pragma unroll
    for (int e = 0; e < 8; ++e) s[e] = 0.f;
#pragma unroll
    for (int j = 0; j < WIN - 1; ++j)
#pragma unroll
        for (int e = 0; e < 8; ++e) s[e] += bfe(R[j], e);
#pragma unroll
    for (int i = 0; i < 8; ++i) { const int ts = ts0 + i; const int cnt = (ts + 1 < WIN) ? ts + 1 : WIN; const float inv = frcp((float)cnt); float o[8];
#pragma unroll
        for (int e = 0; e < 8; ++e) { s[e] += bfe(R[WIN - 1 + i], e); o[e] = s[e] * inv - bfe(R[WIN - 1 + i], e); }
        *(LAS bf16x8*)(dst + i * ldp) = pack8(o);
#pragma unroll
        for (int e = 0; e < 8; ++e) s[e] -= bfe(R[i], e); }
}
__device__ __forceinline__ void f_pool(Frame& F, const bf16* proj, const bf16* wT, const float* bias, const float* scale, bf16* mix) {
    LAS bf16* P = (LAS bf16*)F.lds; constexpr int LDP = 264;
    const int lane = fresh_tid() & 63, wave = F.wave;
    for (int tile = F.bid; tile < MG / 128; tile += F.G) {
        const int tok0 = tile * 128;
        bf16x8 wfr[2][4];
#pragma unroll
        for (int ks = 0; ks < 2; ++ks)
#pragma unroll
            for (int nt = 0; nt < 4; ++nt) wfr[ks][nt] = *(const GAS bf16x8*)((wT + ((wave >> 1) * 64) * 64 + 32 * ks) + prow32(nt, lane & 15) * 64 + 8 * (lane >> 4));
        {   const int g = wave & 3, cg = (lane & 7) + 8 * g, tr = (wave >> 2) * 8 + (lane >> 3), r0 = tr * 8;
            const int ts0 = (tok0 & (SEQ - 1)) + r0;
            const bf16* col = proj + (size_t)(tok0 + r0) * NPROJ + 8 * cg; LAS bf16* dst = P + r0 * LDP + 8 * cg;
            if (g == 0) pool_run<2>(col, ts0, dst, LDP); else if (g == 1) pool_run<4>(col, ts0, dst, LDP); else if (g == 2) pool_run<8>(col, ts0, dst, LDP); else pool_run<16>(col, ts0, dst, LDP);
        }
        __syncthreads();
        {   const int g = wave >> 1, th = wave & 1, fr = lane & 15, fq = lane >> 4;
            f32x4 acc[4][4];
#pragma unroll
            for (int a = 0; a < 4; ++a)
#pragma unroll
                for (int b = 0; b < 4; ++b) acc[a][b] = (f32x4){0.f, 0.f, 0.f, 0.f};
#pragma unroll
            for (int ks = 0; ks < 2; ++ks) { bf16x8 afr[4];
#pragma unroll
                for (int mt = 0; mt < 4; ++mt) afr[mt] = *(const LAS bf16x8*)(P + (64 * th + 16 * mt + fr) * LDP + 64 * g + 32 * ks + 8 * fq);
#pragma unroll
                for (int mt = 0; mt < 4; ++mt)
#pragma unroll
                    for (int nt = 0; nt < 4; ++nt) acc[mt][nt] = mfma16(wfr[ks][nt], afr[mt], acc[mt][nt]); }
#pragma unroll
            for (int a = 0; a < 2; ++a) { const int c = 64 * g + 32 * a + 8 * fq;
                const f32x4 bi0 = *(const GAS f32x4*)(bias + c), bi1 = *(const GAS f32x4*)(bias + c + 4), sc0 = *(const GAS f32x4*)(scale + c), sc1 = *(const GAS f32x4*)(scale + c + 4);
#pragma unroll
                for (int mt = 0; mt < 4; ++mt) { const int tok = tok0 + 64 * th + 16 * mt + fr;
                    *(GAS bf16x8*)(mix + (size_t)tok * DM + c) = pack8v((acc[mt][2 * a] + bi0) * sc0, (acc[mt][2 * a + 1] + bi1) * sc1); } }
        }
        __syncthreads();
    }
}

__device__ __forceinline__ void f_sconv(Frame& F, const bf16* proj, const float* w, bf16* mix) {
    for (int tile = F.bid; tile < MG / 128; tile += F.G) {
        const int tid_ = fresh_tid();
        const int tok0 = tile * 128, cg = tid_ & 31, tr = tid_ >> 5, r0 = 8 * tr, ts0 = (tok0 & (SEQ - 1)) + r0;
        const bf16* base = proj + (size_t)(tok0 + r0) * NPROJ + 8 * cg;
        float w0[8], w1[8], w2[8], pm2[8], pm1[8];
#pragma unroll
        for (int e = 0; e < 8; ++e) { w0[e] = w[8 * cg + e]; w1[e] = w[256 + 8 * cg + e]; w2[e] = w[512 + 8 * cg + e]; pm2[e] = 0.f; pm1[e] = 0.f; }
        { const bf16x8 a2 = row_or_zero(base - 2 * (ptrdiff_t)NPROJ + 1024, ts0 - 2), b2 = row_or_zero(base - 2 * (ptrdiff_t)NPROJ + 1280, ts0 - 2), a1 = row_or_zero(base - (ptrdiff_t)NPROJ + 1024, ts0 - 1), b1 = row_or_zero(base - (ptrdiff_t)NPROJ + 1280, ts0 - 1);
#pragma unroll
          for (int e = 0; e < 8; ++e) { pm2[e] = bfe(a2, e) * bfe(b2, e); pm1[e] = bfe(a1, e) * bfe(b1, e); } }
#pragma unroll
        for (int i = 0; i < 8; ++i) { const bf16* r = base + (ptrdiff_t)i * NPROJ;
            const bf16x8 cb = *(const GAS bf16x8*)(r + 768), cc = *(const GAS bf16x8*)(r + 1024), ch = *(const GAS bf16x8*)(r + 1280); float o[8];
#pragma unroll
            for (int e = 0; e < 8; ++e) { const float p = bfe(cc, e) * bfe(ch, e); o[e] = bfe(cb, e) * (w0[e] * pm2[e] + w1[e] * pm1[e] + w2[e] * p); pm2[e] = pm1[e]; pm1[e] = p; }
            *(GAS bf16x8*)(mix + (size_t)(tok0 + r0 + i) * DM + 512 + 8 * cg) = pack8(o); }
    }
}

__device__ __forceinline__ void f_sgu(Frame& F, const bf16* proj, const float* ln_g, const float* ln_b, const bf16* swm, const float* sb, bf16* mix) {
    LAS bf16* VT = (LAS bf16*)F.lds; constexpr int LDV = 136;
    const int lane = fresh_tid() & 63, wave = F.wave, fr = lane & 15, fq = lane >> 4;
    const int h = wave >> 1, cb0 = 64 * h + 32 * (wave & 1);
    const unsigned aoff = fr * 128 + 8 * fq, uoff = fr * NPROJ + 8 * fq, moff = fr * DM + 8 * fq;
    for (int tile = F.bid; tile < MG / 128; tile += F.G) {
        const int tok0 = tile * 128;
        u32x2 raw[16];
#pragma unroll
        for (int i = 0; i < 16; ++i) raw[i] = *(const GAS u32x2*)((proj + (size_t)(tok0 + 16 * wave + i) * NPROJ + 512) + 4 * lane);
        bf16x8 afr[4][8];
#pragma unroll
        for (int mt = 0; mt < 8; ++mt) afr[0][mt] = *(const GAS bf16x8*)((swm + (h * 128 + 16 * mt) * 128) + aoff);
        {   const f32x4 gv = *(const GAS f32x4*)(ln_g + 4 * lane), bv = *(const GAS f32x4*)(ln_b + 4 * lane);
#pragma unroll
            for (int bt = 0; bt < 2; ++bt) { const int t0 = 16 * wave + 8 * bt; f32x4 v[8]; float mu[8], rs[8];
#pragma unroll
                for (int i = 0; i < 8; ++i) v[i] = unpack4(raw[8 * bt + i]);
#pragma unroll
                for (int i = 0; i < 8; ++i) mu[i] = wave_sum((v[i].x + v[i].y) + (v[i].z + v[i].w)) * (1.0f / 256.0f);
#pragma unroll
                for (int i = 0; i < 8; ++i) { v[i] = v[i] - mu[i]; rs[i] = frsq(wave_sum((v[i].x * v[i].x + v[i].y * v[i].y) + (v[i].z * v[i].z + v[i].w * v[i].w)) * (1.0f / 256.0f) + EPS); }
#pragma unroll
                for (int e = 0; e < 4; ++e) { float o[8];
#pragma unroll
                    for (int i = 0; i < 8; ++i) o[i] = v[i][e] * rs[i] * gv[e] + bv[e];
                    *(LAS bf16x8*)(VT + (4 * lane + e) * LDV + t0) = pack8(o); } }
        }
        asm volatile("" ::: "memory");
#pragma unroll
        for (int mt = 0; mt < 8; ++mt) afr[1][mt] = *(const GAS bf16x8*)((swm + (h * 128 + 16 * mt) * 128 + 32) + aoff);
#pragma unroll
        for (int ks = 2; ks < 4; ++ks)
#pragma unroll
            for (int mt = 4; mt < 8; ++mt) afr[ks][mt] = *(const GAS bf16x8*)((swm + (h * 128 + 16 * mt) * 128 + 32 * ks) + aoff);
        v4u ur[8]; float bsv[8];
#pragma unroll
        for (int mt = 0; mt < 8; ++mt) { bsv[mt] = sb[h * 128 + 16 * mt + fr];
            ur[mt] = *(const GAS v4u*)((proj + (size_t)(tok0 + 16 * mt) * NPROJ + 256 + cb0) + uoff); }
        __syncthreads();
        {   f32x4 acc[8][2];
#pragma unroll
            for (int a = 0; a < 8; ++a) { acc[a][0] = (f32x4){0.f, 0.f, 0.f, 0.f}; acc[a][1] = (f32x4){0.f, 0.f, 0.f, 0.f}; }
#pragma unroll
            for (int ks = 0; ks < 4; ++ks) { bf16x8 bfr[2];
#pragma unroll
                for (int nt = 0; nt < 2; ++nt) bfr[nt] = *(const LAS bf16x8*)(VT + (cb0 + prow32(nt, fr)) * LDV + 32 * ks + 8 * fq);
#pragma unroll
                for (int mt = 0; mt < 8; ++mt) { if (ks >= 2 && mt < 4) continue;
                    acc[mt][0] = mfma16(bfr[0], afr[ks][mt], acc[mt][0]); acc[mt][1] = mfma16(bfr[1], afr[ks][mt], acc[mt][1]); } }
#pragma unroll
            for (int mt = 0; mt < 8; ++mt) { const v4u u = ur[mt];
                *(GAS bf16x8*)((mix + (size_t)(tok0 + 16 * mt) * DM + 256 + cb0) + moff) = pack8v(unpack4((u32x2){u.x, u.y}) * (acc[mt][0] + bsv[mt]), unpack4((u32x2){u.z, u.w}) * (acc[mt][1] + bsv[mt])); }
        }
        __syncthreads();
    }
}

__device__ __forceinline__ void ssd_stage_weights(const float* cw, const float* cb, LAS float* WL) {
    const int tid = fresh_tid();
    for (int i = tid; i < 768; i += NWAVES * 64) { *(LAS f32x4*)(WL + 4 * i) = *(const GAS f32x4*)(cw + 4 * i); }
    for (int i = tid; i < 192; i += NWAVES * 64) { *(LAS f32x4*)(WL + 3072 + 4 * i) = *(const GAS f32x4*)(cb + 4 * i); }
    __syncthreads();
}
__device__ __forceinline__ void ssd_rows11(const bf16* src, int ts0, bf16x8 (&R)[11]) {
#pragma unroll
    for (int k = 0; k < 11; ++k) R[k] = row_or_zero(src + (ptrdiff_t)(k - 3) * NPROJ, ts0 + k - 3);
}
typedef float f32x2m __attribute__((ext_vector_type(2)));
__device__ __forceinline__ f32x2m bf2pair(unsigned d) { return (f32x2m){__builtin_bit_cast(float, d << 16), __builtin_bit_cast(float, d & 0xffff0000u)}; }
__device__ __forceinline__ f32x2m silu2(f32x2m a) { const f32x2m t = a * -1.4426950408889634f; f32x2m e; e.x = __builtin_amdgcn_exp2f(t.x); e.y = __builtin_amdgcn_exp2f(t.y);
    const f32x2m d = e + 1.0f; f32x2m r; r.x = __builtin_amdgcn_rcpf(d.x); r.y = __builtin_amdgcn_rcpf(d.y); return a * r; }
template <int NT> __device__ __forceinline__ void ssd_conv8xN(const bf16x8 (&R)[NT + 3], const LAS float* cw, const LAS float* cb, float (&out)[NT][8]) {
    f32x4 wv[4][2], bv[2];
#pragma unroll
    for (int k = 0; k < 4; ++k) { wv[k][0] = *(const LAS f32x4*)(cw + k * 768); wv[k][1] = *(const LAS f32x4*)(cw + k * 768 + 4); }
    bv[0] = *(const LAS f32x4*)cb; bv[1] = *(const LAS f32x4*)(cb + 4);
#pragma unroll
    for (int ep = 0; ep < 4; ++ep) { f32x2m w2[4]; const f32x2m b2 = {bv[ep >> 1][2 * (ep & 1)], bv[ep >> 1][2 * (ep & 1) + 1]};
#pragma unroll
        for (int k = 0; k < 4; ++k) w2[k] = (f32x2m){wv[k][ep >> 1][2 * (ep & 1)], wv[k][ep >> 1][2 * (ep & 1) + 1]};
        f32x2m x2[NT + 3];
#pragma unroll
        for (int j = 0; j < NT + 3; ++j) x2[j] = bf2pair(__builtin_bit_cast(v4u, R[j])[ep]);
#pragma unroll
        for (int i = 0; i < NT; ++i) { f32x2m a2 = b2;
#pragma unroll
            for (int k = 0; k < 4; ++k) a2 += w2[k] * x2[i + k];
            const f32x2m s2 = silu2(a2); out[i][2 * ep] = s2.x; out[i][2 * ep + 1] = s2.y; } }
}
__device__ __forceinline__ void ssd_conv8x8(const bf16x8 (&R)[11], const LAS float* cw, const LAS float* cb, float (&out)[8][8]) { ssd_conv8xN<8>(R, cw, cb, out); }
__device__ __forceinline__ void ssd_conv8x4(const bf16x8 (&R)[7], const LAS float* cw, const LAS float* cb, float (&out)[4][8]) { ssd_conv8xN<4>(R, cw, cb, out); }
__device__ __forceinline__ void ssd_delta_acs(float dtv, int h, int lane, const float* dt_bias, const float* a_log, float& delta, float& acs) {
    delta = softplus_f(dtv + dt_bias[h]);
    float x = delta * -fexp(a_log[h]);
#pragma unroll
    for (int o = 1; o < 64; o <<= 1) { const float y = __builtin_bit_cast(float, __builtin_amdgcn_ds_bpermute(4 * (lane - o), __builtin_bit_cast(int, x))); if (lane >= o) x += y; }
    acs = x;
}

__device__ __forceinline__ void f_ssd_states(Frame& F, const bf16* proj, float* dt, const float* dtp, const float* ssqp, const float* cw, const float* cb, const float* dt_bias, const float* a_log, bf16* ST, float* DEC, unsigned long long& tprev, unsigned long long& tacc) {
#define MSTAMP(id) do { if (TSLOT >= 40 && TSLOT < 50) { const unsigned long long n_ = __builtin_amdgcn_s_memrealtime(); if ((id) == TSLOT) tacc += n_ - tprev; tprev = n_; } } while (0)
    constexpr int LDT = 72;
    LAS bf16* XT = (LAS bf16*)F.lds; LAS bf16* BT = XT + 256 * LDT; LAS float* WG = (LAS float*)(F.lds + 2 * 256 * LDT * 2); LAS float* WL = WG + 512;
    const int lane = fresh_tid() & 63, wave = F.wave;
    {   const int ci = wave >> 2, hh = wave & 3, chunk = F.bid + ci * F.G;
        if (chunk < MG / 64) { const size_t tok = (size_t)chunk * 64 + lane; float dtv;
            if (dtp) { float q = 0.f, d = 0.f;
#pragma unroll
                for (int p4 = 0; p4 < 16; ++p4) q += ssqp[(size_t)p4 * P_STRIDE + tok];
#pragma unroll
                for (int p = 0; p < 16; ++p) d += dtp[((size_t)p * P_STRIDE + tok) * 4 + hh];
                dtv = d * frsq(q * (1.0f / DM) + EPS); dt[tok * 4 + hh] = dtv; }
            else dtv = dt[tok * 4 + hh];
            float delta, acs; ssd_delta_acs(dtv, hh, lane, dt_bias, a_log, delta, acs);
            const float aend = __builtin_bit_cast(float, __builtin_amdgcn_readlane(__builtin_bit_cast(int, acs), 63)); WG[(ci * 4 + hh) * 64 + lane] = delta * fexp(aend - acs);
            if (lane == 63) DEC[chunk * 4 + hh] = fexp(acs); }
    }
    ssd_stage_weights(cw, cb, WL);
    int ci = 0;
    for (int chunk = F.bid; chunk < MG / 64; chunk += F.G, ++ci) {
        const int tok0 = chunk * 64, ts0 = tok0 & (SEQ - 1);
        const int tr = lane & 7, cg = (lane >> 3) + 8 * wave, r0 = 8 * tr;
        bf16x8 R[11]; ssd_rows11(proj + (size_t)(tok0 + r0) * NPROJ + 1792 + 8 * cg, ts0 + r0, R);
        MSTAMP(40);
        {   float out[8][8];
            ssd_conv8x8(R, WL + 8 * cg, WL + 3072 + 8 * cg, out);
            if (wave < 4) { const int h = cg >> 3;
#pragma unroll
                for (int i = 0; i < 8; ++i) { const float wg = WG[(ci * 4 + h) * 64 + r0 + i];
#pragma unroll
                    for (int e = 0; e < 8; ++e) out[i][e] *= wg; } }
            LAS bf16* dst = (wave < 4 ? XT : BT) + (8 * (cg & 31)) * LDT + r0;
#pragma unroll
            for (int e = 0; e < 8; ++e) { float o[8];
#pragma unroll
                for (int i = 0; i < 8; ++i) o[i] = out[i][e];
                *(LAS bf16x8*)(dst + e * LDT) = pack8(o); }
        }
        __syncthreads(); MSTAMP(41);
        {   const int h = wave >> 1, nh = wave & 1, g = h >> 1, fr = lane & 15, fq = lane >> 4;
            f32x4 acc[4][4];
#pragma unroll
            for (int a = 0; a < 4; ++a)
#pragma unroll
                for (int b = 0; b < 4; ++b) acc[a][b] = (f32x4){0.f, 0.f, 0.f, 0.f};
#pragma unroll
            for (int ks = 0; ks < 2; ++ks) { bf16x8 xfr[4], nfr[4];
#pragma unroll
                for (int mt = 0; mt < 4; ++mt) xfr[mt] = *(const LAS bf16x8*)(XT + (64 * h + 16 * mt + fr) * LDT + 32 * ks + 8 * fq);
#pragma unroll
                for (int nt = 0; nt < 4; ++nt) nfr[nt] = *(const LAS bf16x8*)(BT + (128 * g + 64 * nh + prow32(nt, fr)) * LDT + 32 * ks + 8 * fq);
#pragma unroll
                for (int mt = 0; mt < 4; ++mt)
#pragma unroll
                    for (int nt = 0; nt < 4; ++nt) acc[mt][nt] = mfma16(nfr[nt], xfr[mt], acc[mt][nt]); }
#pragma unroll
            for (int mt = 0; mt < 4; ++mt)
#pragma unroll
                for (int a = 0; a < 2; ++a) *(GAS bf16x8*)(ST + ((size_t)(chunk * 4 + h) * 64 + 16 * mt + fr) * 128 + 64 * nh + 32 * a + 8 * fq) = pack8v(acc[mt][2 * a], acc[mt][2 * a + 1]);
        }
        __syncthreads(); MSTAMP(42);
    }
}
__device__ __forceinline__ void f_ssd_scan(Frame& F, const bf16* ST, const float* DEC, bf16* PV) {
    const int tid_ = fresh_tid();
    for (int e = F.bid * 512 + tid_; e < (MG / SEQ) * 4 * 64 * 32; e += F.G * 512) { const int n4 = e & 31, p = (e >> 5) & 63, h = (e >> 11) & 3, b = e >> 13;
        const size_t idx0 = ((size_t)((b * (SEQ / 64)) * 4 + h) * 64 + p) * 128 + 4 * n4; constexpr size_t CSTR = (size_t)4 * 64 * 128;
        u32x2 S[SEQ / 64]; float dec[SEQ / 64];
#pragma unroll
        for (int c = 0; c < SEQ / 64; ++c) { S[c] = *(const GAS u32x2*)(ST + idx0 + c * CSTR); dec[c] = DEC[(b * (SEQ / 64) + c) * 4 + h]; }
        float z_ = 0.f; asm volatile("" : "+v"(z_));
        f32x4 c0 = {z_, z_, z_, z_};
#pragma unroll
        for (int c = 0; c < SEQ / 64; ++c) { u32x2 o; o.x = pk2(c0.x, c0.y); o.y = pk2(c0.z, c0.w); *(GAS u32x2*)(PV + idx0 + c * CSTR) = o;
            c0 = c0 * dec[c] + unpack4(S[c]); } }
}
__device__ __forceinline__ void f_ssd_out(Frame& F, const bf16* proj, const float* dt, const float* cw, const float* cb, const float* dt_bias, const float* a_log, const float* dsk, const float* ng, const bf16* PV, bf16* mix, unsigned long long& tprev, unsigned long long& tacc) {
#define ISTAMP(id) do { if (TSLOT >= 30) { const unsigned long long n_ = __builtin_amdgcn_s_memrealtime(); if ((id) == TSLOT) tacc += n_ - tprev; tprev = n_; } } while (0)
    constexpr int LDN = 264, LDT = 72;
    LAS bf16* CN = (LAS bf16*)F.lds; LAS bf16* BN = CN + 64 * LDN; LAS bf16* XDT = BN + 64 * LDN; LAS bf16* SC = XDT + 256 * LDT;
    LAS float* ACS0 = (LAS float*)(SC + 4 * 64 * LDT); LAS float* DL0 = ACS0 + 512; LAS float* SSQ = DL0 + 512; LAS float* WL = SSQ + 256;
    static_assert(2 * 64 * LDN * 2 + 256 * LDT * 2 + 4 * 64 * LDT * 2 + 5 * 1024 + 3840 * 4 <= LDSCTL_OFF, "ssd_out LDS");
    const int lane = fresh_tid() & 63, wave = F.wave, fr = lane & 15, fq = lane >> 4;
    {   const int ci_ = wave >> 2, hh_ = wave & 3, chunk_ = F.bid + ci_ * F.G;
        if (chunk_ < MG / 64) { float delta, acs; ssd_delta_acs(dt[((size_t)chunk_ * 64 + lane) * 4 + hh_], hh_, lane, dt_bias, a_log, delta, acs); DL0[(ci_ * 4 + hh_) * 64 + lane] = delta; ACS0[(ci_ * 4 + hh_) * 64 + lane] = acs; } }
    ssd_stage_weights(cw, cb, WL);
    int ci = 0;
    for (int chunk = F.bid; chunk < MG / 64; chunk += F.G, ++ci) {
        const LAS float* ACS = ACS0 + ci * 256; const LAS float* DL = DL0 + ci * 256;
        const int tok0 = chunk * 64, ts0 = tok0 & (SEQ - 1);
        const int h3 = wave >> 1, mp = wave & 1, g3 = h3 >> 1;
        const int tr4 = lane & 15, cgl = 4 * wave + fq, r0 = 4 * tr4;
        bf16x8 R[3][7];
#define SSD_LOAD_ROWS(j) _Pragma("unroll") for (int k = 0; k < 7; ++k) R[j][k] = row_or_zero(proj + (size_t)(tok0 + r0 + k - 3) * NPROJ + 1792 + 256 * (j) + 8 * cgl, ts0 + r0 + k - 3);
        SSD_LOAD_ROWS(0) SSD_LOAD_ROWS(1)
        ISTAMP(30);
        if (!(SSD_SKIP & 1)) {   float out[4][8];
            ssd_conv8x4(R[0], WL + 8 * cgl, WL + 3072 + 8 * cgl, out);
            { const int h = cgl >> 3;
#pragma unroll
              for (int i = 0; i < 4; ++i) { const float dl = DL[h * 64 + r0 + i];
#pragma unroll
                  for (int e = 0; e < 8; ++e) out[i][e] *= dl; }
#pragma unroll
              for (int e = 0; e < 8; ++e) *(LAS u32x2*)(XDT + (8 * cgl + e) * LDT + r0) = pack4((f32x4){out[0][e], out[1][e], out[2][e], out[3][e]}); }
            asm volatile("" ::: "memory"); SSD_LOAD_ROWS(2)
            ssd_conv8x4(R[1], WL + 256 + 8 * cgl, WL + 3072 + 256 + 8 * cgl, out);
#pragma unroll
            for (int i = 0; i < 4; ++i) *(LAS bf16x8*)(BN + (r0 + i) * LDN + 8 * cgl) = pack8(out[i]);
            ssd_conv8x4(R[2], WL + 512 + 8 * cgl, WL + 3072 + 512 + 8 * cgl, out);
#pragma unroll
            for (int i = 0; i < 4; ++i) *(LAS bf16x8*)(CN + (r0 + i) * LDN + 8 * cgl) = pack8(out[i]);
        }
        bf16x8 pfr[4][4];
#pragma unroll
        for (int ks = 0; ks < 4; ++ks)
#pragma unroll
            for (int nt = 0; nt < 4; ++nt) pfr[ks][nt] = *(const GAS bf16x8*)(PV + ((size_t)(chunk * 4 + h3) * 64 + prow32(nt, fr)) * 128 + 32 * ks + 8 * fq);
        v4u zr[2][2];
#pragma unroll
        for (int mi = 0; mi < 2; ++mi)
#pragma unroll
            for (int a = 0; a < 2; ++a) zr[mi][a] = *(const GAS v4u*)((proj + (size_t)(tok0 + 16 * (2 * mp + mi)) * NPROJ + 1536 + 64 * h3 + 32 * a) + fr * NPROJ + 8 * fq);
        __syncthreads(); ISTAMP(31);
        if (!(SSD_SKIP & 2)) {
            const int g = wave >> 2, mt = wave & 3, l = 16 * mt + fr;
#pragma unroll
            for (int nt = 0; nt < 4; ++nt) { f32x4 G = {0.f, 0.f, 0.f, 0.f};
                if (nt <= mt) {
#pragma unroll
                    for (int ks = 0; ks < 4; ++ks) { const bf16x8 cfr = *(const LAS bf16x8*)(CN + (16 * mt + fr) * LDN + 128 * g + 32 * ks + 8 * fq), bfr = *(const LAS bf16x8*)(BN + (16 * nt + fr) * LDN + 128 * g + 32 * ks + 8 * fq);
                        G = mfma16(bfr, cfr, G); } }
                const int s0 = 16 * nt + 4 * fq;
#pragma unroll
                for (int hh = 0; hh < 2; ++hh) { const int h = 2 * g + hh; const float al = ACS[h * 64 + l]; f32x4 v;
                    const float dsk_l = dsk[h] * frcp(fmaxf(DL[h * 64 + l], 1e-30f));
#pragma unroll
                    for (int r = 0; r < 4; ++r) { v[r] = (s0 + r <= l) ? G[r] * fexp(al - ACS[h * 64 + s0 + r]) : 0.f; if (s0 + r == l) v[r] += dsk_l; }
                    *(LAS u32x2*)(SC + (h * 64 + l) * LDT + s0) = pack4(v); } }
        }
#undef SSD_LOAD_ROWS
        __syncthreads(); ISTAMP(32);
        f32x4 y[2][4] = {};
        if (!(SSD_SKIP & 4)) {
#pragma unroll
            for (int mi = 0; mi < 2; ++mi) { const int mt = 2 * mp + mi, l = 16 * mt + fr;
                f32x4 accd[4], acco[4];
#pragma unroll
                for (int nt = 0; nt < 4; ++nt) { accd[nt] = (f32x4){0.f, 0.f, 0.f, 0.f}; acco[nt] = (f32x4){0.f, 0.f, 0.f, 0.f}; }
#pragma unroll
                for (int ks = 0; ks < 2; ++ks) { const bf16x8 sfr = *(const LAS bf16x8*)(SC + (h3 * 64 + 16 * mt + fr) * LDT + 32 * ks + 8 * fq);
#pragma unroll
                    for (int nt = 0; nt < 4; ++nt) { const bf16x8 xfr = *(const LAS bf16x8*)(XDT + (64 * h3 + prow32(nt, fr)) * LDT + 32 * ks + 8 * fq); accd[nt] = mfma16(xfr, sfr, accd[nt]); } }
#pragma unroll
                for (int ks = 0; ks < 4; ++ks) { const bf16x8 cfr = *(const LAS bf16x8*)(CN + (16 * mt + fr) * LDN + 128 * g3 + 32 * ks + 8 * fq);
#pragma unroll
                    for (int nt = 0; nt < 4; ++nt) acco[nt] = mfma16(pfr[ks][nt], cfr, acco[nt]); }
                const float ea = fexp(ACS[h3 * 64 + l]); float q = 0.f;
#pragma unroll
                for (int nt = 0; nt < 4; ++nt) {
                    const v4u zz = zr[mi][nt >> 1]; const f32x4 z = (nt & 1) ? unpack4((u32x2){zz.z, zz.w}) : unpack4((u32x2){zz.x, zz.y});
                    f32x4 v = accd[nt] + ea * acco[nt];
#pragma unroll
                    for (int r = 0; r < 4; ++r) { v[r] *= silu_fast(z[r]); q += v[r] * v[r]; }
                    y[mi][nt] = v; }
                q += lane_xor<16>(q); q = add_xor32(q);
                if (lane < 16) SSQ[h3 * 64 + l] = q; }
        }
        __syncthreads(); ISTAMP(33);
#pragma unroll
        for (int mi = 0; mi < 2; ++mi) { const int l = 16 * (2 * mp + mi) + fr;
            const float rs = frsq((SSQ[(2 * g3) * 64 + l] + SSQ[(2 * g3 + 1) * 64 + l]) * (1.0f / 128.0f) + EPS);
#pragma unroll
            for (int a = 0; a < 2; ++a) { const int pc = 64 * h3 + 32 * a + 8 * fq; const f32x4 gn0 = *(const GAS f32x4*)(ng + pc), gn1 = *(const GAS f32x4*)(ng + pc + 4);
                *(GAS bf16x8*)(mix + (size_t)(tok0 + l) * DM + 768 + pc) = pack8v(y[mi][2 * a] * rs * gn0, y[mi][2 * a + 1] * rs * gn1); } }
        __syncthreads(); ISTAMP(34);
    }
}
#define PHASE_STAGGER(T) do { if ((T) > 0) { const unsigned long long t0_ = __builtin_amdgcn_s_memrealtime(); const unsigned long long d_ = (unsigned long long)(F.bid * (T)); while (__builtin_amdgcn_s_memrealtime() - t0_ < d_) __builtin_amdgcn_s_sleep(1); } } while (0)
__device__ __forceinline__ void p_wdt(Frame& F, const float* w_in, const float* g, bf16* wdt) {
    for (int k = F.gbid * 512 + fresh_tid(); k < DM; k += F.GG * 512) { const f32x4 w = *(const GAS f32x4*)(w_in + (size_t)k * INCOLS + NPROJ) * g[k];
        wdt[k] = (bf16)f2bf(w.x); wdt[DM + k] = (bf16)f2bf(w.y); wdt[2 * DM + k] = (bf16)f2bf(w.z); wdt[3 * DM + k] = (bf16)f2bf(w.w); }
}
template <class Sched, class E_> __device__ __forceinline__ void fill_rstd_issue(Frame& F, const Sched& S, const float* P, E_& E) {
    pg8::Unit u0, ul; if (!S.next(0, u0)) { E.pmA = 0; return; } ul = u0; { const int n = (S.nwg - S.c + S.G - 1) / S.G; if (n > 1) S.next(n - 1, ul); }
    const int tid_ = fresh_tid();
    const int slot = tid_ >> 8, r = tid_ & 255; const size_t row = (size_t)(slot ? ul.pm : u0.pm) * 256 + r;
#pragma unroll
    for (int p4 = 0; p4 < 16; ++p4) E.pv[p4] = P[(size_t)p4 * P_STRIDE + row];
    E.pmA = u0.pm;
}
__global__ void __launch_bounds__(NWAVES * 64, 2) mega_fwd(Args args) {
    extern __shared__ __attribute__((aligned(16))) unsigned char lds[];
    Frame F0;
    F0.lds = (LAS unsigned char*)lds;
    F0.MISC = (volatile LAS unsigned*)(F0.lds + MISC_OFF);
    F0.wave = __builtin_amdgcn_readfirstlane((int)threadIdx.x >> 6);
    F0.GG = gridDim.x; F0.gbid = blockIdx.x; F0.gvcu = (F0.GG % 8 == 0) ? (F0.gbid % 8) * (F0.GG / 8) + F0.gbid / 8 : F0.gbid;
#if GROUP_SPREAD
    constexpr int NXG = 8;
    const int grp0 = (F0.gbid >> 3) % NGROUPS;
    F0.G = F0.GG / NGROUPS; F0.bid = (F0.gbid & 7) + 8 * (F0.gbid / (8 * NGROUPS)); F0.vcu = (F0.bid % NXG) * (F0.G / NXG) + F0.bid / NXG;
#define GRP_OF_BLOCK() ((int)((blockIdx.x >> 3) % NGROUPS))
#else
    constexpr int NXG = 8 / NGROUPS;
    const int grp0 = (F0.gbid & 7) / NXG;
    F0.G = F0.GG / NGROUPS; F0.bid = (F0.gbid & 7) % NXG + NXG * (F0.gbid >> 3); F0.vcu = (F0.bid % NXG) * (F0.G / NXG) + F0.bid / NXG;
#define GRP_OF_BLOCK() ((int)((blockIdx.x & 7) / NXG))
#endif
    unsigned char* ws = args.ws;
    F0.ctl = (gu32*)(ws + WS_CTL);
    for (int u = threadIdx.x; u < (LDS_BYTES - LDSCTL_OFF) / 4; u += NWAVES * 64) ((LAS unsigned*)(F0.lds + LDSCTL_OFF))[u] = 0u;
    __syncthreads();
    (void)xcd_barrier_post((unsigned*)(args.ws + WS_CTL) + CW_BAR, F0.MISC + 8);
    (void)xcd_barrier_post((unsigned*)(args.ws + WS_CTL) + CW_BAR + (1 + grp0) * XCD_BAR_WORDS, F0.MISC + 10);
#define GLOBAL_BAR() do { XcdBarrier b_; b_.bar = (unsigned*)(args.ws + WS_CTL) + CW_BAR; b_.x = xb_xcc_id(); b_.st = (volatile LAS unsigned*)((LAS unsigned char*)lds + MISC_OFF) + 8; b_.G = gridDim.x; xcd_barrier(b_); } while (0)
#define GRID_BAR() do { for (int rb_ = 0; rb_ < REP_BAR; ++rb_) { XcdBarrier b_; b_.bar = (unsigned*)(args.ws + WS_CTL) + CW_BAR + (1 + GRP_OF_BLOCK()) * XCD_BAR_WORDS; b_.x = xb_xcc_id(); b_.st = (volatile LAS unsigned*)((LAS unsigned char*)lds + MISC_OFF) + 10; b_.G = gridDim.x / NGROUPS; xcd_barrier(b_); } } while (0)
#if TSLOT >= 0
    unsigned long long t_prev_ = __builtin_amdgcn_s_memrealtime(), t_acc_ = 0ull, c_prev_ = __builtin_amdgcn_s_memtime(), c_acc_ = 0ull, r_acc_ = 1ull;
#define TSTAMP(id) do { const unsigned long long t_now_ = __builtin_amdgcn_s_memrealtime(); const unsigned long long c_now_ = __builtin_amdgcn_s_memtime(); if ((id) == TSLOT) t_acc_ += t_now_ - t_prev_; if ((id) == 9) { c_acc_ += c_now_ - c_prev_; r_acc_ += t_now_ - t_prev_; } t_prev_ = t_now_; c_prev_ = c_now_; } while (0)
#else
#define TSTAMP(id) do {} while (0)
    unsigned long long t_prev_ = 0ull, t_acc_ = 0ull;
#endif
#define in args.in
    constexpr size_t SSQ_STRIDE = (size_t)M * 16;
#define PHASE_PTRS \
    GAS unsigned char* w_ = (GAS unsigned char*)args.ws; int l_ = l, grp_ = grp0; asm volatile("" : "+s"(w_), "+s"(l_), "+s"(grp_));     const int grp = grp_; const size_t r0 = (size_t)grp * MG; \
    Frame Fp = F0; asm volatile("" : "+s"(Fp.bid), "+s"(Fp.G), "+s"(Fp.vcu)); Frame& F = Fp; \
    float* out = args.out + r0 * DM; (void)out; \
    bf16* HB = (bf16*)(w_ + WS_HB) + r0 * DM; unsigned char* actg = (unsigned char*)(w_ + WS_ACT + (size_t)grp * ACT_GROUP_BYTES); \
    bf16* PROJ = (bf16*)actg; bf16* MIX = (bf16*)(actg + (size_t)MG * NPROJ * 2); bf16* HID = (bf16*)actg; (void)HB; (void)PROJ; (void)MIX; (void)HID; \
    float* DT = (float*)(w_ + WS_DT) + r0 * 4; bf16* ST = (bf16*)(w_ + WS_ST) + (r0 / 64) * 4 * 64 * 128; float* DEC = (float*)(w_ + WS_DEC) + (r0 / 64) * 4; bf16* PV = (bf16*)(w_ + WS_PV) + (r0 / 64) * 4 * 64 * 128; (void)DT; (void)ST; (void)DEC; (void)PV; \
    float* SSQ = (float*)(w_ + WS_SSQ) + r0; float* DTP = (float*)(w_ + WS_DTP) + r0 * 4; bf16* WDT = (bf16*)(w_ + WS_WDT); (void)DTP; (void)WDT; \
    bf16* win_t = (bf16*)(w_ + WS_WIN) + (size_t)l_ * NPROJ * DM; bf16* wout_t = (bf16*)(w_ + WS_WOUT) + (size_t)l_ * DM * DM; \
    bf16* wgu_t = (bf16*)(w_ + WS_WGU) + (size_t)l_ * NGU * DM; bf16* wdn_t = (bf16*)(w_ + WS_WDN) + (size_t)l_ * DM * DFF; (void)win_t; (void)wout_t; (void)wgu_t; (void)wdn_t; \
    float* ssq_mix = SSQ + (size_t)(2 * l_) * SSQ_STRIDE; float* ssq_ffn = SSQ + (size_t)(2 * l_ + 1) * SSQ_STRIDE; float* ssq_next = SSQ + (size_t)(2 * l_ + 2) * SSQ_STRIDE; (void)ssq_mix; (void)ssq_ffn; (void)ssq_next;

#pragma unroll 1
    for (int it_ = 0; it_ < DEPTH * REP_P0; ++it_) { const int l = it_ % DEPTH;
        PHASE_PTRS
        p_transpose(F, in[2] + (size_t)l_ * DM * INCOLS, DM, INCOLS, NPROJ / 32, win_t, 0, in[1] + l_ * DM);
        p_transpose(F, in[17] + (size_t)l_ * DM * DM, DM, DM, DM / 32, wout_t, 0, nullptr);
        p_transpose(F, in[19] + (size_t)l_ * DM * DFF, DM, DFF, DFF / 32, wgu_t, 1, in[18] + l_ * DM);
        p_transpose(F, in[20] + (size_t)l_ * DM * DFF, DM, DFF, DFF / 32, wgu_t, 2, in[18] + l_ * DM);
        p_transpose(F, in[21] + (size_t)l_ * DFF * DM, DFF, DM, DM / 32, wdn_t, 0, nullptr);
        p_small_weights(F, in[3] + l_ * 4 * 64 * 64, (bf16*)(w_ + WS_PW) + l_ * 4 * 64 * 64, in[8] + l_ * 4 * 128 * 128, (bf16*)(w_ + WS_SW) + l_ * 4 * 128 * 128);
        p_wdt(F, in[2] + (size_t)l_ * DM * INCOLS, in[1] + l_ * DM, WDT + (size_t)l_ * DM * 4);
    }
    { const int l = 0; PHASE_PTRS
      for (int rep_ = 0; rep_ < REP_XPASS; ++rep_) p_xpass(F, in[0] + r0 * DM, in[1], in[2] + NPROJ, HB, SSQ, DT); }
    GLOBAL_BAR(); TSTAMP(0);
    if (SKEW_US > 0 && grp0 > 0) { const unsigned long long t0_ = __builtin_amdgcn_s_memrealtime(); while (__builtin_amdgcn_s_memrealtime() - t0_ < (unsigned long long)(grp0 * SKEW_US * 100)) __builtin_amdgcn_s_sleep(8); }
#pragma clang loop unroll(full)
    for (int l = 0; l < DEPTH; ++l) {
        { PHASE_PTRS
          pg8::Gemm g{HB, win_t, MG, NPROJ, DM, 0}; pg8::StaticOrder S; S.init(MG, NPROJ, F.G, F.bid); pg8::EpiProj E{PROJ, (const LAS float*)(F.lds + RT_OFF), 0, NPROJ}; fill_rstd_issue(F, S, ssq_mix, E);
          PHASE_STAGGER(STAG_G1);
          for (int rep_ = 0; rep_ < REP_G1; ++rep_) pg8::gemm_phase<pg8::EpiProj, pg8::StaticOrder, GEMM_ALIGN, GEMM_SP2>(F.lds, g, S, E); }
        GRID_BAR(); TSTAMP(1);
        { PHASE_PTRS
          for (int rep_ = 0; rep_ < REP_M1; ++rep_) f_ssd_states(F, PROJ, DT, l_ > 0 ? DTP : nullptr, ssq_mix, in[11] + l_ * 4 * 768, in[12] + l_ * 768, in[13] + l_ * 4, in[14] + l_ * 4, ST, DEC, t_prev_, t_acc_); }
        TSTAMP(20);
        { PHASE_PTRS
          for (int rep_ = 0; rep_ < REP_POOL; ++rep_) f_pool(F, PROJ, (const bf16*)(w_ + WS_PW) + l_ * 4 * 64 * 64, in[4] + l_ * 256, in[5] + l_ * 256, MIX); }
        TSTAMP(21);
        { PHASE_PTRS
          for (int rep_ = 0; rep_ < REP_SGU; ++rep_) f_sgu(F, PROJ, in[6] + l_ * 256, in[7] + l_ * 256, (const bf16*)(w_ + WS_SW) + l_ * 4 * 128 * 128, in[9] + l_ * 4 * 128, MIX); }
        TSTAMP(22);
        { PHASE_PTRS
          for (int rep_ = 0; rep_ < REP_SCONV; ++rep_) f_sconv(F, PROJ, in[10] + l_ * 3 * 256, MIX); }
        TSTAMP(23);
        GRID_BAR(); TSTAMP(2);
        { PHASE_PTRS
          for (int rep_ = 0; rep_ < REP_SCAN; ++rep_) f_ssd_scan(F, ST, DEC, PV); }
        GRID_BAR(); TSTAMP(3);
        { PHASE_PTRS
          for (int rep_ = 0; rep_ < REP_SSDOUT; ++rep_) f_ssd_out(F, PROJ, DT, in[11] + l_ * 4 * 768, in[12] + l_ * 768, in[13] + l_ * 4, in[14] + l_ * 4, in[15] + l_ * 4, in[16] + l_ * 256, PV, MIX, t_prev_, t_acc_); }
        GRID_BAR(); TSTAMP(4);
        { PHASE_PTRS
          pg8::Gemm g{MIX, wout_t, MG, DM, DM, 0}; pg8::StaticOrder S; S.init(MG, DM, F.G, F.bid);
          { pg8::EpiRes<false, false, false> E{HB, HB, ssq_ffn, nullptr, nullptr, DM, 0}; pg8::gemm_phase<pg8::EpiRes<false, false, false>, pg8::StaticOrder, GEMM_ALIGN, GEMM_SP2>(F.lds, g, S, E); } }
#if PROBE_G2
        { PHASE_PTRS
          pg8::Gemm g{MIX, wout_t, MG, DM, DM, 0}; pg8::StaticOrder S; S.init(MG, DM, F.G, F.bid);
          pg8::EpiRes<false, false, false> E{HB, (bf16*)ST, (float*)PV, nullptr, nullptr, DM, PROBE_NOP}; pg8::gemm_phase<pg8::EpiRes<false, false, false>, pg8::StaticOrder, GEMM_ALIGN, GEMM_SP2>(F.lds, g, S, E); }
#endif
        GRID_BAR(); TSTAMP(5);
        { PHASE_PTRS
          pg8::Gemm g{HB, wgu_t, MG, NGU, DM, 0}; pg8::StaticOrder S; S.init(MG, NGU, F.G, F.bid); pg8::EpiSwiGLU E{HID, (const LAS float*)(F.lds + RT_OFF), 0, DFF}; fill_rstd_issue(F, S, ssq_ffn, E);
          PHASE_STAGGER(STAG_G3);
          for (int rep_ = 0; rep_ < REP_G3; ++rep_) pg8::gemm_phase<pg8::EpiSwiGLU, pg8::StaticOrder, GEMM_ALIGN, GEMM_SP2>(F.lds, g, S, E); }
        GRID_BAR(); TSTAMP(6);
        { PHASE_PTRS
          pg8::Gemm g{HID, wdn_t, MG, DM, DFF, 0}; pg8::StaticOrder S; S.init(MG, DM, F.G, F.bid);
          if (l_ + 1 < DEPTH) { pg8::EpiRes<false, false, true> E{HB, HB, ssq_next, WDT + (size_t)(l_ + 1) * DM * 4, DTP, DM, 0}; pg8::gemm_phase<pg8::EpiRes<false, false, true>, pg8::StaticOrder, GEMM_ALIGN, GEMM_SP2>(F.lds, g, S, E); }
#if FUSE_FINAL
          else { pg8::EpiResFinal E{HB, out, (unsigned*)ssq_next, (unsigned*)(w_ + WS_CTL) + CW_FIN, in[22], (unsigned*)(w_ + WS_CTL) + 8, DM, (int)(r0 / 256)}; pg8::gemm_phase<pg8::EpiResFinal, pg8::StaticOrder, GEMM_ALIGN, GEMM_SP2>(F.lds, g, S, E); } }
#else
          else { pg8::EpiRes<false, false, false> E{HB, HB, ssq_next, nullptr, nullptr, DM, 0}; pg8::gemm_phase<pg8::EpiRes<false, false, false>, pg8::StaticOrder, GEMM_ALIGN, GEMM_SP2>(F.lds, g, S, E); } }
#endif
#if PROBE_G4
        { PHASE_PTRS
          pg8::Gemm g{HID, wdn_t, MG, DM, DFF, 0}; pg8::StaticOrder S; S.init(MG, DM, F.G, F.bid);
          pg8::EpiRes<false, false, false> E{HB, (bf16*)ST, (float*)PV, nullptr, nullptr, DM, PROBE_NOP}; pg8::gemm_phase<pg8::EpiRes<false, false, false>, pg8::StaticOrder, GEMM_ALIGN, GEMM_SP2>(F.lds, g, S, E); }
#endif
        if (!FUSE_FINAL || l + 1 < DEPTH) { GRID_BAR(); } TSTAMP(7);
    }
#if PROBE_KLOOP == 1
    { const int l = 0; PHASE_PTRS
      pg8::Gemm g{HB, wgu_t, MG, NGU, DM, 0}; pg8::FixedOrder S{11}; pg8::EpiNull E;
      pg8::gemm_phase<pg8::EpiNull, pg8::FixedOrder, true, true>(F.lds, g, S, E); }
    GRID_BAR(); TSTAMP(9);
#elif PROBE_KLOOP == 2
    { const int l = 0; PHASE_PTRS
      pg8::Gemm g{HB, wgu_t, MG, NGU, DM, 0}; pg8::StaticOrder S; S.init(MG, NGU, F.G, F.bid); pg8::EpiNull E;
      pg8::gemm_phase<pg8::EpiNull, pg8::StaticOrder, GEMM_ALIGN, GEMM_SP2>(F.lds, g, S, E); }
    GRID_BAR(); TSTAMP(9);
#elif PROBE_KLOOP == 3
    { const int l = 0; PHASE_PTRS
      pg8::Gemm g{HID, wdn_t, MG, DM, DFF, 0}; pg8::StaticOrder S; S.init(MG, DM, F.G, F.bid); pg8::EpiNull E;
      pg8::gemm_phase<pg8::EpiNull, pg8::StaticOrder, GEMM_ALIGN, GEMM_SP2>(F.lds, g, S, E); }
    GRID_BAR(); TSTAMP(9);
#elif PROBE_KLOOP == 4
    { const int l = 0; PHASE_PTRS
      pg8::Gemm g{HID, wdn_t, MG, DM, DFF, 0}; pg8::FixedOrder S{2}; pg8::EpiNull E;
      pg8::gemm_phase<pg8::EpiNull, pg8::FixedOrder, true, true>(F.lds, g, S, E); }
    GRID_BAR(); TSTAMP(9);
#elif PROBE_KLOOP == 8
    { const int l = 0; PHASE_PTRS
      pg8::Gemm g{HB, wgu_t, MG, PROBE_N, DM, 0}; pg8::StaticOrder S; S.init(MG, PROBE_N, F.G, F.bid); pg8::EpiNull E;
      pg8::gemm_phase<pg8::EpiNull, pg8::StaticOrder, GEMM_ALIGN, GEMM_SP2>(F.lds, g, S, E); }
    GRID_BAR(); TSTAMP(9);
#elif PROBE_KLOOP == 9
    { const int l = 0; PHASE_PTRS
      pg8::Gemm g{HB, win_t, MG, PROBE_N, DM, 0}; pg8::StaticOrder S; S.init(MG, PROBE_N, F.G, F.bid); pg8::EpiNull E;
      pg8::gemm_phase<pg8::EpiNull, pg8::StaticOrder, GEMM_ALIGN, GEMM_SP2>(F.lds, g, S, E); }
    GRID_BAR(); TSTAMP(9);
#elif PROBE_KLOOP == 5
    { const int l = 0; PHASE_PTRS
      pg8::Gemm g{HB, win_t, MG, NPROJ, DM, 0}; pg8::StaticOrder S; S.init(MG, NPROJ, F.G, F.bid); pg8::EpiNull E;
      pg8::gemm_phase<pg8::EpiNull, pg8::StaticOrder, GEMM_ALIGN, GEMM_SP2>(F.lds, g, S, E); }
    GRID_BAR(); TSTAMP(9);
#elif PROBE_KLOOP == 6 || PROBE_KLOOP == 7
    { const int l = 0; PHASE_PTRS
      pg8::Gemm g{HB, win_t, MG, NPROJ, DM, 0}; pg8::StaticOrder S; S.init(MG, NPROJ, F.G, F.bid); pg8::EpiProjT<PROBE_KLOOP == 6> E{PROJ, (const LAS float*)(F.lds + RT_OFF), 0, NPROJ}; fill_rstd_issue(F, S, ssq_mix, E);
      pg8::gemm_phase<pg8::EpiProjT<PROBE_KLOOP == 6>, pg8::StaticOrder, GEMM_ALIGN, GEMM_SP2>(F.lds, g, S, E); }
    GRID_BAR(); TSTAMP(9);
#endif
#if !FUSE_FINAL
    { const int l = DEPTH; PHASE_PTRS
      p_finalnorm(F, HB, out, SSQ + (size_t)(2 * DEPTH) * SSQ_STRIDE, in[22]); }
#endif
#if TSLOT >= 0
    TSTAMP(10);
    if (blockIdx.x == 0 && threadIdx.x == 0) { asm volatile("s_waitcnt vmcnt(0)" ::: "memory"); args.out[0] = TSLOT == 99 ? (float)(((c_acc_ * 100ull / r_acc_) / CQ) * CQ) : TSLOT == 98 ? (float)(((c_acc_ / 176ull) / CQ) * CQ) : TQUANT > 0 ? (float)((t_acc_ / (100ull * TQUANT)) * TQUANT) : (float)t_acc_ * 0.01f; }
#endif
#undef in
}

extern "C" void kernel_launch(void* const* d_in, const int* in_sizes, int n_in, void* d_out, int out_size, void* d_ws, size_t ws_size, hipStream_t stream) {
    static int grid = 0;
    if (grid == 0) {
        if (n_in != 23 || out_size != M * DM || ws_size < WS_END) { fprintf(stderr, "kernel_launch: unexpected shapes (n_in %d out %d ws %zu)\n", n_in, out_size, ws_size); grid = -1; return; }
        int dev = 0, cus = 0, per_cu = 0;
        if (hipGetDevice(&dev) != hipSuccess || hipDeviceGetAttribute(&cus, hipDeviceAttributeMultiprocessorCount, dev) != hipSuccess) { grid = -1; return; }
        if (hipFuncSetAttribute((const void*)mega_fwd, hipFuncAttributeMaxDynamicSharedMemorySize, LDS_BYTES) != hipSuccess) { fprintf(stderr, "kernel_launch: hipFuncSetAttribute failed\n"); grid = -1; return; }
        if (hipOccupancyMaxActiveBlocksPerMultiprocessor(&per_cu, (const void*)mega_fwd, NWAVES * 64, LDS_BYTES) != hipSuccess || per_cu < 1) { fprintf(stderr, "kernel_launch: occupancy query says %d blocks per CU\n", per_cu); (void)hipGetLastError(); grid = -1; return; }
        grid = cus;
        if (grid != 256) { fprintf(stderr, "kernel_launch: built for a 256-CU device (one workgroup per CU, 8 batch groups of 32); this device reports %d CUs; nothing launched\n", cus); grid = -1; return; }
        if (MG / 64 > 2 * (grid / NGROUPS)) { fprintf(stderr, "kernel_launch: more than two SSD chunks per workgroup; nothing launched\n"); grid = -1; return; }
        { const int Ns[3] = {NPROJ, DM, NGU}; bool ok = true;
          for (int t = 0; t < 3 && ok; ++t) for (int c = 0; c < grid / NGROUPS && ok; ++c) { pg8::StaticOrder S; S.init(MG, Ns[t], grid / NGROUPS, c); pg8::Unit u, u0, ul; if (!S.next(0, u0)) continue; ul = u0; for (int i = 1; S.next(i, u); ++i) ul = u;
              for (int i = 0; S.next(i, u); ++i) if (u.pm != u0.pm && u.pm != ul.pm) ok = false; }
          if (!ok) { fprintf(stderr, "kernel_launch: the unit order gives a workgroup more than two row panels; nothing launched\n"); grid = -1; return; } }
    }
    if (grid < 0) return;
    if (hipMemsetAsync((char*)d_ws + WS_CTL, 0, CTL_ZERO_BYTES, stream) != hipSuccess) { fprintf(stderr, "kernel_launch: memset failed\n"); return; }
    Args a{};
    for (int i = 0; i < 23; ++i) a.in[i] = (const float*)d_in[i];
    a.out = (float*)d_out; a.ws = (unsigned char*)d_ws;
    hipLaunchKernelGGL(mega_fwd, dim3(grid), dim3(NWAVES * 64), LDS_BYTES, stream, a);
}
```

```cpp
#include <hip/hip_runtime.h>
#include <cstdio>
#include <cstdint>
#ifndef NGROUPS
#define NGROUPS 8
#endif
#ifndef GROUP_SPREAD
#define GROUP_SPREAD 0
#endif
#define PG8_NXCD (GROUP_SPREAD ? 8 : 8 / NGROUPS)
#ifndef PG8_WGM
#define PG8_WGM (GROUP_SPREAD ? 1 : 8)
#endif
#define P_STRIDE 32768
#ifndef NT_STORES
#define NT_STORES 4
#endif
#ifndef EPI_TEST
#define EPI_TEST 0
#endif
template <int MASK> __device__ __forceinline__ float lane_xor(float v) {
    static_assert(MASK > 0 && MASK < 32, "lane_xor: MASK 1..31");
    return __builtin_bit_cast(float, __builtin_amdgcn_ds_swizzle(__builtin_bit_cast(int, v), (MASK << 10) | 0x1f));
}
template <int CTRL> __device__ __forceinline__ float dpp_f(float v) {
    return __builtin_bit_cast(float, __builtin_amdgcn_update_dpp(0, __builtin_bit_cast(int, v), CTRL, 0xF, 0xF, true));
}
__device__ __forceinline__ float add_xor32(float v) {
    const auto r = __builtin_amdgcn_permlane32_swap(__builtin_bit_cast(unsigned, v), __builtin_bit_cast(unsigned, v), false, false);
    return __builtin_bit_cast(float, (unsigned)r[0]) + __builtin_bit_cast(float, (unsigned)r[1]);
}
namespace pg8 {
#define PG8_LAS __attribute__((address_space(3)))
typedef unsigned short bf16_t;
typedef short bf16x8 __attribute__((ext_vector_type(8)));
typedef float f32x4 __attribute__((ext_vector_type(4)));
typedef unsigned u32x4 __attribute__((ext_vector_type(4)));
constexpr int BM = 256, BK = 64, HALF = 128, HTB = HALF * BK * 2  , STAGE_BYTES = 8 * HTB, NXCD = PG8_NXCD, WGM = PG8_WGM;

__host__ __device__ __forceinline__ int lds_byte(int r, int c) { const int st = (r >> 4) * 2 + (c >> 5), rr = r & 15, cc = c & 31, ob = rr * 64 + cc * 2; return st * 1024 + (ob ^ (((ob >> 9) & 1) << 5)); }
__host__ __device__ __forceinline__ void stage_rc(int b, int& R, int& C) { const int st = b / 1024, sb = b % 1024, swz = sb ^ (((sb >> 9) & 1) << 5); R = (st >> 1) * 16 + swz / 64; C = (st & 1) * 32 + (swz % 64) / 2; }
__host__ __device__ __forceinline__ int perm32(int rho) { const int n = rho >> 4, i = rho & 15; return 8 * (i >> 2) + 4 * n + (i & 3); }

struct Unit { int pm, pn; };
struct Gemm { const bf16_t* A; const bf16_t* Bt; int M, N, K, pad; };

struct StaticOrder {
    int nM, nN, nwg, G, c;
    __host__ __device__ void init(int M, int N, int G_, int c_) { nM = M / BM; nN = N / BM; nwg = nM * nN; G = G_; c = c_; }
    __host__ __device__ bool next(int i, Unit& u) const {
        const long L = (long)i * G + c; if (L >= nwg) return false;
        int wgid = (int)L; { const int q = nwg / NXCD, r = nwg % NXCD, xcd = wgid % NXCD, off = wgid / NXCD; wgid = (xcd < r ? xcd * (q + 1) : r * (q + 1) + (xcd - r) * q) + off; }
        const int nig = WGM * nN, gid = wgid / nig, fm = gid * WGM, gsz = (nM - fm) < WGM ? (nM - fm) : WGM;
        u.pm = fm + ((wgid % nig) % gsz); u.pn = (wgid % nig) / gsz; return true;
    }
    __device__ __forceinline__ void a_ready(const Unit&) const {}
    __device__ __forceinline__ void done(const Unit&) const {}
};

__device__ __forceinline__ unsigned cvt_pk_bf16(float lo, float hi) { unsigned r; asm volatile("v_cvt_pk_bf16_f32 %0, %1, %2" : "=v"(r) : "v"(lo), "v"(hi)); return r; }
typedef float f32x2 __attribute__((ext_vector_type(2)));
__device__ __forceinline__ f32x2 gelu_pk(f32x2 v) {
    const f32x2 av = __builtin_elementwise_abs(v), d = av * 0.2316418882f + 1.0f;
    f32x2 t; t.x = __builtin_amdgcn_rcpf(d.x); t.y = __builtin_amdgcn_rcpf(d.y);
    f32x2 q = t * 0.5307027145f + (-0.7265760135f); q = q * t + 0.7107068705f; q = q * t + (-0.142248368f); q = q * t + 0.127414796f; q = q * t;
    const f32x2 s = (v * v) * (-0.72134752044f);
    f32x2 e; e.x = __builtin_amdgcn_exp2f(s.x); e.y = __builtin_amdgcn_exp2f(s.y);
    const f32x2 m = v * (q * e), r = v - m;
    f32x2 o; o.x = v.x < 0.f ? m.x : r.x; o.y = v.y < 0.f ? m.y : r.y; return o;
}

template <int ACT  > struct EpiBf16 {
    static constexpr bool PERM = true, AFTER_DRAIN = false; static_assert(ACT == 0 || ACT == 1, "EpiBf16: ACT is 0 (none) or 1 (gelu_pk)");
    bf16_t* O; const float* bias; size_t split_stride; int ldc; int split_cols; float scale0; int pad;
    __device__ __forceinline__ void operator()(const f32x4 (&acc)[2][2][4][2], const Unit& u, int wr, int wc, int fr, int fq) const {
        const int row0 = u.pm * BM + wr * 64 + fr; int colt = u.pn * BM; bf16_t* base = O;
        float sc = 1.f; if (split_cols) { const int t = colt / split_cols; base += (size_t)t * split_stride; colt -= t * split_cols; if (t == 0) sc = scale0; }
        const int col0 = colt + wc * 32 + 8 * fq, bcol0 = u.pn * BM + wc * 32 + 8 * fq;
        f32x4 bv[2][2];
#pragma unroll
        for (int bj = 0; bj < 2; ++bj)
#pragma unroll
            for (int n = 0; n < 2; ++n) bv[bj][n] = bias ? *(const f32x4*)(bias + bcol0 + bj * HALF + 4 * n) : (f32x4){0.f, 0.f, 0.f, 0.f};
#pragma unroll
        for (int ai = 0; ai < 2; ++ai)
#pragma unroll
            for (int m = 0; m < 4; ++m) { bf16_t* rowp = base + (size_t)(row0 + ai * HALF + m * 16) * ldc + col0;
#pragma unroll
                for (int bj = 0; bj < 2; ++bj) { f32x4 v0 = acc[ai][bj][m][0] + bv[bj][0], v1 = acc[ai][bj][m][1] + bv[bj][1];
                    if (ACT == 1) { f32x2 a = gelu_pk((f32x2){v0[0], v0[1]}), b = gelu_pk((f32x2){v0[2], v0[3]}), c = gelu_pk((f32x2){v1[0], v1[1]}), d = gelu_pk((f32x2){v1[2], v1[3]});
                        v0 = (f32x4){a.x, a.y, b.x, b.y}; v1 = (f32x4){c.x, c.y, d.x, d.y}; }
                    v0 = v0 * sc; v1 = v1 * sc; u32x4 w; w.x = cvt_pk_bf16(v0[0], v0[1]); w.y = cvt_pk_bf16(v0[2], v0[3]); w.z = cvt_pk_bf16(v1[0], v1[1]); w.w = cvt_pk_bf16(v1[2], v1[3]);
                    *(u32x4*)(rowp + bj * HALF) = w; } }
    }
};
__device__ __forceinline__ float silu_f(float x) { return x * __builtin_amdgcn_rcpf(1.0f + __builtin_amdgcn_exp2f(-1.4426950408889634f * x)); }
template <bool STORE> struct EpiProjT {
    static constexpr bool PERM = true, AFTER_DRAIN = false;
    bf16_t* O; const PG8_LAS float* rt; int pmA; int ldc;
    float pv[16];
    __device__ __forceinline__ void pre() const {
        int t_ = threadIdx.x; asm volatile("" : "+v"(t_));
        float q[16];
#pragma unroll
        for (int i = 0; i < 16; ++i) q[i] = pv[i];
        asm volatile("" : "+v"(q[0]), "+v"(q[1]), "+v"(q[2]), "+v"(q[3]), "+v"(q[4]), "+v"(q[5]), "+v"(q[6]), "+v"(q[7]), "+v"(q[8]), "+v"(q[9]), "+v"(q[10]), "+v"(q[11]), "+v"(q[12]), "+v"(q[13]), "+v"(q[14]), "+v"(q[15]) :: "memory");
        float s = 0.f;
#pragma unroll
        for (int i = 0; i < 16; ++i) s += q[i];
        ((PG8_LAS float*)rt)[t_] = __builtin_amdgcn_rsqf(s * (1.0f / 1024.0f) + 1e-6f);
        __syncthreads();
    }
    __device__ __forceinline__ void operator()(const f32x4 (&acc)[2][2][4][2], const Unit& u, int wr, int wc, int fr, int fq) const {
        const int row0 = u.pm * BM + wr * 64 + fr, col0 = u.pn * BM + wc * 32 + 8 * fq; const PG8_LAS float* rtp = rt + (u.pm != pmA ? 256 : 0) + wr * 64 + fr;
        float rsv[8];
#pragma unroll
        for (int i = 0; i < 8; ++i) rsv[i] = rtp[(i >> 2) * HALF + (i & 3) * 16];
        asm volatile("" : "+v"(rsv[0]), "+v"(rsv[1]), "+v"(rsv[2]), "+v"(rsv[3]), "+v"(rsv[4]), "+v"(rsv[5]), "+v"(rsv[6]), "+v"(rsv[7]));
#pragma unroll
        for (int ai = 0; ai < 2; ++ai)
#pragma unroll
            for (int m = 0; m < 4; ++m) { const int row = row0 + ai * HALF + m * 16; const float rs = rsv[ai * 4 + m]; bf16_t* rowp = O + (size_t)row * ldc + col0;
#pragma unroll
                for (int bj = 0; bj < 2; ++bj) { const f32x4 v0 = acc[ai][bj][m][0] * rs, v1 = acc[ai][bj][m][1] * rs; u32x4 w;
                    w.x = cvt_pk_bf16(v0[0], v0[1]); w.y = cvt_pk_bf16(v0[2], v0[3]); w.z = cvt_pk_bf16(v1[0], v1[1]); w.w = cvt_pk_bf16(v1[2], v1[3]);
                    if (!STORE && w.x != 0x7fc1u) continue;
                    if (NT_STORES & 1) __builtin_nontemporal_store(w, (u32x4*)(rowp + bj * HALF)); else *(u32x4*)(rowp + bj * HALF) = w; } }
    }
};
using EpiProj = EpiProjT<true>;
struct EpiSwiGLU {
    static constexpr bool PERM = true, AFTER_DRAIN = false;
    bf16_t* O; const PG8_LAS float* rt; int pmA; int ldc;
    float pv[16];
    __device__ __forceinline__ void pre() const {
        int t_ = threadIdx.x; asm volatile("" : "+v"(t_));
        float q[16];
#pragma unroll
        for (int i = 0; i < 16; ++i) q[i] = pv[i];
        asm volatile("" : "+v"(q[0]), "+v"(q[1]), "+v"(q[2]), "+v"(q[3]), "+v"(q[4]), "+v"(q[5]), "+v"(q[6]), "+v"(q[7]), "+v"(q[8]), "+v"(q[9]), "+v"(q[10]), "+v"(q[11]), "+v"(q[12]), "+v"(q[13]), "+v"(q[14]), "+v"(q[15]) :: "memory");
        float s = 0.f;
#pragma unroll
        for (int i = 0; i < 16; ++i) s += q[i];
        ((PG8_LAS float*)rt)[t_] = __builtin_amdgcn_rsqf(s * (1.0f / 1024.0f) + 1e-6f);
        __syncthreads();
    }
    __device__ __forceinline__ void operator()(const f32x4 (&acc)[2][2][4][2], const Unit& u, int wr, int wc, int fr, int fq) const {
        const int row0 = u.pm * BM + wr * 64 + fr, col0 = u.pn * HALF + wc * 32 + 8 * fq; const PG8_LAS float* rtp = rt + (u.pm != pmA ? 256 : 0) + wr * 64 + fr;
        float rsv[8];
#pragma unroll
        for (int i = 0; i < 8; ++i) rsv[i] = rtp[(i >> 2) * HALF + (i & 3) * 16];
        asm volatile("" : "+v"(rsv[0]), "+v"(rsv[1]), "+v"(rsv[2]), "+v"(rsv[3]), "+v"(rsv[4]), "+v"(rsv[5]), "+v"(rsv[6]), "+v"(rsv[7]));
#pragma unroll
        for (int ai = 0; ai < 2; ++ai)
#pragma unroll
            for (int m = 0; m < 4; ++m) { const int row = row0 + ai * HALF + m * 16; const float rs = rsv[ai * 4 + m]; bf16_t* rowp = O + (size_t)row * ldc + col0;
                const float c1 = -1.4426950408889634f * rs, irs2 = __builtin_amdgcn_rcpf(rs * rs);
                u32x4 w;
                f32x2 g2[4], u2[4], t2[4];
#pragma unroll
                for (int q = 0; q < 4; ++q) { const f32x4 gq = acc[ai][0][m][q >> 1], uq = acc[ai][1][m][q >> 1]; g2[q] = (f32x2){gq[2 * (q & 1)], gq[2 * (q & 1) + 1]}; u2[q] = (f32x2){uq[2 * (q & 1)], uq[2 * (q & 1) + 1]}; }
#pragma unroll
                for (int q = 0; q < 4; ++q) t2[q] = g2[q] * c1;
#pragma unroll
                for (int q = 0; q < 4; ++q) { t2[q].x = __builtin_amdgcn_exp2f(t2[q].x); t2[q].y = __builtin_amdgcn_exp2f(t2[q].y); }
#pragma unroll
                for (int q = 0; q < 4; ++q) { t2[q] = t2[q] * irs2 + irs2; g2[q] = g2[q] * u2[q]; }
#pragma unroll
                for (int q = 0; q < 4; ++q) { t2[q].x = __builtin_amdgcn_rcpf(t2[q].x); t2[q].y = __builtin_amdgcn_rcpf(t2[q].y); }
#pragma unroll
                for (int q = 0; q < 4; ++q) { const f32x2 h2 = g2[q] * t2[q]; w[q] = cvt_pk_bf16(h2.x, h2.y); }
                if (NT_STORES & 4) __builtin_nontemporal_store(w, (u32x4*)rowp); else *(u32x4*)rowp = w; }
    }
};
template <bool BASE_F32, bool OUT_F32, bool WITH_DT> struct EpiRes {
    static constexpr bool PERM = true, AFTER_DRAIN = false;
    const void* base; void* out; float* P; const void* wdt  ; float* DTP; int ldc; int pad;
    __device__ __forceinline__ void operator()(const f32x4 (&acc)[2][2][4][2], const Unit& u, int wr, int wc, int fr, int fq) const {
        const int row0 = u.pm * BM + wr * 64 + fr, col0 = u.pn * BM + wc * 32 + 8 * fq, slot = u.pn * 4 + wc;
        bf16x8 wdf[2] = {{0, 0, 0, 0, 0, 0, 0, 0}, {0, 0, 0, 0, 0, 0, 0, 0}};
        if constexpr (WITH_DT) { if (fr < 4) { wdf[0] = *(const bf16x8*)((const bf16_t*)wdt + (size_t)fr * 1024 + col0); wdf[1] = *(const bf16x8*)((const bf16_t*)wdt + (size_t)fr * 1024 + col0 + HALF); } }
        u32x4 bh[BASE_F32 ? 1 : 2][BASE_F32 ? 1 : 4][2];
        if constexpr (!BASE_F32) {
#pragma unroll
            for (int ai = 0; ai < 2; ++ai)
#pragma unroll
                for (int m = 0; m < 4; ++m)
#pragma unroll
                    for (int bj = 0; bj < 2; ++bj) bh[ai][m][bj] = *(const u32x4*)((const bf16_t*)base + (size_t)(row0 + ai * HALF + m * 16) * ldc + col0 + bj * HALF);
            asm volatile("" ::: "memory"); }
#pragma unroll
        for (int ai = 0; ai < 2; ++ai) {
            f32x4 bf0[BASE_F32 ? 4 : 1][2], bf1[BASE_F32 ? 4 : 1][2];
            if constexpr (BASE_F32) {
#pragma unroll
                for (int m = 0; m < 4; ++m)
#pragma unroll
                    for (int bj = 0; bj < 2; ++bj) { const size_t off = (size_t)(row0 + ai * HALF + m * 16) * ldc + col0 + bj * HALF;
                        bf0[m][bj] = *(const f32x4*)((const float*)base + off); bf1[m][bj] = *(const f32x4*)((const float*)base + off + 4); }
                asm volatile("" ::: "memory"); }
#pragma unroll
            for (int m = 0; m < 4; ++m) { const int row = row0 + ai * HALF + m * 16; const size_t off = (size_t)row * ldc + col0;
                f32x4 v[2][2]; float s = 0.f;
#pragma unroll
                for (int bj = 0; bj < 2; ++bj) { f32x4 b0, b1;
                    if constexpr (BASE_F32) { b0 = bf0[m][bj]; b1 = bf1[m][bj]; }
                    else { const u32x4 r = bh[BASE_F32 ? 0 : ai][BASE_F32 ? 0 : m][bj];
                        b0 = (f32x4){__builtin_bit_cast(float, r.x << 16), __builtin_bit_cast(float, r.x & 0xffff0000u), __builtin_bit_cast(float, r.y << 16), __builtin_bit_cast(float, r.y & 0xffff0000u)};
                        b1 = (f32x4){__builtin_bit_cast(float, r.z << 16), __builtin_bit_cast(float, r.z & 0xffff0000u), __builtin_bit_cast(float, r.w << 16), __builtin_bit_cast(float, r.w & 0xffff0000u)}; }
                    v[bj][0] = acc[ai][bj][m][0] + b0; v[bj][1] = acc[ai][bj][m][1] + b1;
#pragma unroll
                    for (int n = 0; n < 2; ++n) s += (v[bj][n][0] * v[bj][n][0] + v[bj][n][1] * v[bj][n][1]) + (v[bj][n][2] * v[bj][n][2] + v[bj][n][3] * v[bj][n][3]); }
                s += lane_xor<16>(s); s = add_xor32(s);
                if (fq == 0 && !pad) P[(size_t)slot * P_STRIDE + row] = s;
                f32x4 d = {0.f, 0.f, 0.f, 0.f};
#pragma unroll
                for (int bj = 0; bj < 2; ++bj) {
                    if constexpr (OUT_F32) { *(f32x4*)((float*)out + off + bj * HALF) = v[bj][0]; *(f32x4*)((float*)out + off + bj * HALF + 4) = v[bj][1]; }
                    else { u32x4 w; w.x = cvt_pk_bf16(v[bj][0][0], v[bj][0][1]); w.y = cvt_pk_bf16(v[bj][0][2], v[bj][0][3]); w.z = cvt_pk_bf16(v[bj][1][0], v[bj][1][1]); w.w = cvt_pk_bf16(v[bj][1][2], v[bj][1][3]);
                        if (NT_STORES & 2) __builtin_nontemporal_store(w, (u32x4*)((bf16_t*)out + off + bj * HALF)); else *(u32x4*)((bf16_t*)out + off + bj * HALF) = w;
                        if constexpr (WITH_DT) d = __builtin_amdgcn_mfma_f32_16x16x32_bf16(wdf[bj], __builtin_bit_cast(bf16x8, w), d, 0, 0, 0); } }
                if constexpr (WITH_DT) { if (fq == 0) *(f32x4*)(DTP + ((size_t)slot * P_STRIDE + row) * 4) = d; } } }
    }
};

struct EpiResFinal {
    static constexpr bool PERM = true, AFTER_DRAIN = false;
    const bf16_t* base; float* out; unsigned* P; unsigned* cnt; const float* g; unsigned* tmo; int ldc; int panel0;
    __device__ __forceinline__ void operator()(const f32x4 (&acc_)[2][2][4][2], const Unit& u, int wr, int wc, int fr, int fq) const {
        f32x4 (&acc)[2][2][4][2] = const_cast<f32x4 (&)[2][2][4][2]>(acc_);
        const int row0 = u.pm * BM + wr * 64 + fr, col0 = u.pn * BM + wc * 32 + 8 * fq, slot = u.pn * 4 + wc;
#pragma unroll
        for (int ai = 0; ai < 2; ++ai) { u32x4 bh[4][2];
#pragma unroll
            for (int m = 0; m < 4; ++m)
#pragma unroll
                for (int bj = 0; bj < 2; ++bj) bh[m][bj] = *(const u32x4*)(base + (size_t)(row0 + ai * HALF + m * 16) * ldc + col0 + bj * HALF);
            asm volatile("" ::: "memory");
#pragma unroll
            for (int m = 0; m < 4; ++m) { const int row = row0 + ai * HALF + m * 16; float s = 0.f;
#pragma unroll
                for (int bj = 0; bj < 2; ++bj) { const u32x4 r = bh[m][bj];
                    const f32x4 b0 = {__builtin_bit_cast(float, r.x << 16), __builtin_bit_cast(float, r.x & 0xffff0000u), __builtin_bit_cast(float, r.y << 16), __builtin_bit_cast(float, r.y & 0xffff0000u)};
                    const f32x4 b1 = {__builtin_bit_cast(float, r.z << 16), __builtin_bit_cast(float, r.z & 0xffff0000u), __builtin_bit_cast(float, r.w << 16), __builtin_bit_cast(float, r.w & 0xffff0000u)};
                    acc[ai][bj][m][0] += b0; acc[ai][bj][m][1] += b1;
#pragma unroll
                    for (int n = 0; n < 2; ++n) { const f32x4 v = acc[ai][bj][m][n]; s += (v[0] * v[0] + v[1] * v[1]) + (v[2] * v[2] + v[3] * v[3]); } }
                s += lane_xor<16>(s); s = add_xor32(s);
                if (fq == 0) __hip_atomic_store(P + (size_t)slot * P_STRIDE + row, __builtin_bit_cast(unsigned, s), __ATOMIC_RELAXED, __HIP_MEMORY_SCOPE_AGENT); } }
        asm volatile("s_waitcnt vmcnt(0)" ::: "memory");
        unsigned* cw = cnt + 64 * (panel0 + u.pm);
        if (fr == 0 && fq == 0) (void)__hip_atomic_fetch_add(cw, 1u, __ATOMIC_RELAXED, __HIP_MEMORY_SCOPE_AGENT);
        { unsigned spins = 0;
          while ((unsigned)__builtin_amdgcn_readfirstlane((int)__hip_atomic_load(cw, __ATOMIC_RELAXED, __HIP_MEMORY_SCOPE_AGENT)) < 32u) {
              __builtin_amdgcn_s_sleep(1);
              if (++spins > (1u << 22)) { if (fr == 0 && fq == 0) __hip_atomic_store(tmo, 1u, __ATOMIC_RELAXED, __HIP_MEMORY_SCOPE_AGENT); break; } } }
        f32x4 gv[2][2];
#pragma unroll
        for (int bj = 0; bj < 2; ++bj) { gv[bj][0] = *(const f32x4*)(g + col0 + bj * HALF); gv[bj][1] = *(const f32x4*)(g + col0 + bj * HALF + 4); }
#pragma unroll
        for (int ai = 0; ai < 2; ++ai)
#pragma unroll
            for (int m = 0; m < 4; ++m) { const int row = row0 + ai * HALF + m * 16; float s = 0.f;
#pragma unroll
                for (int j = 0; j < 4; ++j) s += __builtin_bit_cast(float, __hip_atomic_load(P + (size_t)(4 * fq + j) * P_STRIDE + row, __ATOMIC_RELAXED, __HIP_MEMORY_SCOPE_AGENT));
                s += lane_xor<16>(s); s = add_xor32(s);
                const float rs = 1.0f / __builtin_sqrtf(s * (1.0f / 1024.0f) + 1e-6f);
                float* orow = out + (size_t)row * ldc + col0;
#pragma unroll
                for (int bj = 0; bj < 2; ++bj) { const f32x4 o0 = acc[ai][bj][m][0] * rs * gv[bj][0], o1 = acc[ai][bj][m][1] * rs * gv[bj][1];
                    if (NT_STORES & 8) { __builtin_nontemporal_store(o0, (f32x4*)(orow + bj * HALF)); __builtin_nontemporal_store(o1, (f32x4*)(orow + bj * HALF + 4)); } else { *(f32x4*)(orow + bj * HALF) = o0; *(f32x4*)(orow + bj * HALF + 4) = o1; } } }
    }
};

struct EpiNull {
    static constexpr bool PERM = true, AFTER_DRAIN = false;
    __device__ __forceinline__ void operator()(const f32x4 (&acc)[2][2][4][2], const Unit&, int, int, int, int) const {
#pragma unroll
        for (int a = 0; a < 2; ++a)
#pragma unroll
            for (int b = 0; b < 2; ++b)
#pragma unroll
                for (int m = 0; m < 4; ++m)
#pragma unroll
                    for (int n = 0; n < 2; ++n) asm volatile("" :: "v"(acc[a][b][m][n]));
    }
};
struct FixedOrder {
    int n;
    __device__ bool next(int i, Unit& u) const { if (i >= n) return false; u.pm = 0; u.pn = 0; return true; }
    __device__ __forceinline__ void a_ready(const Unit&) const {}
    __device__ __forceinline__ void done(const Unit&) const {}
};
template <class T, class = void> struct HasPre { static constexpr bool v = false; };
template <class T> struct HasPre<T, decltype((void)&T::pre)> { static constexpr bool v = true; };
template <bool PERM, class Sched>
__device__ __forceinline__ void gemm_prefetch_B(PG8_LAS unsigned char* lds, const Gemm g, const Sched& S) {
    int tid_ = threadIdx.x; asm volatile("" : "+v"(tid_));
    const int tid = tid_, wid = __builtin_amdgcn_readfirstlane(tid >> 6);
    Unit cur; if (!S.next(0, cur)) return;
    const int K = g.K;
    const size_t kstep = (size_t)(BK * 2), hstep = (size_t)HALF * K * 2, tstep = 2 * hstep;
    const unsigned ldsw = (unsigned)wid * 1024u;
    const char* cB = (const char*)g.Bt + (size_t)cur.pn * tstep;
#pragma unroll
    for (int i = 0; i < 2; ++i) { int R, C; stage_rc(tid * 16 + i * 8192, R, C); const int Rb = PERM ? ((R & ~31) + perm32(R & 31)) : R; const unsigned voff = (unsigned)(Rb * K + C) * 2u;
#pragma unroll
        for (int b = 0; b < 2; ++b)
#pragma unroll
            for (int h = 0; h < 2; ++h)
                __builtin_amdgcn_global_load_lds((const unsigned*)(cB + (size_t)b * kstep + (size_t)h * hstep + voff), (PG8_LAS unsigned*)(lds + (4 + b * 2 + h) * HTB + ldsw + i * 8192), 16, 0, 0); }
}
template <class Epi, class Sched, bool ALIGN_EPI = false, bool SP2 = false, bool PREB = false>
__device__ __forceinline__ void gemm_phase(PG8_LAS unsigned char* lds, const Gemm g, const Sched& S, const Epi& E) {
    int tid_ = threadIdx.x; asm volatile("" : "+v"(tid_));
    const int tid = tid_, wid = __builtin_amdgcn_readfirstlane(tid >> 6), lane = tid & 63, wr = wid >> 2, wc = wid & 3, fr = lane & 15, fq = lane >> 4;
    const int K = g.K, nt = K / BK;
    unsigned voffA[2], voffB[2];
#pragma unroll
    for (int i = 0; i < 2; ++i) { int R, C; stage_rc(tid * 16 + i * 8192, R, C); const int Rb = Epi::PERM ? ((R & ~31) + perm32(R & 31)) : R;
        voffA[i] = (unsigned)(R * K + C) * 2u; voffB[i] = (unsigned)(Rb * K + C) * 2u; }
    const size_t kstep = (size_t)(BK * 2);
    const size_t hstep = (size_t)HALF * K * 2;
    const size_t tstep = 2 * hstep;
    const unsigned ldsw = (unsigned)wid * 1024u;
    const int aoff = lds_byte(wr * 64 + fr, fq * 8), boff = lds_byte(wc * 32 + fr, fq * 8);
#define PG8_SA(b, h) (((b) * 2 + (h)) * HTB)
#define PG8_SB(b, h) ((4 + (b) * 2 + (h)) * HTB)
#define PG8_STAGE(bufoff, gbase, voff) do { _Pragma("unroll") for (int _i = 0; _i < 2; ++_i) \
        __builtin_amdgcn_global_load_lds((const unsigned*)((const char*)(gbase) + (voff)[_i]), (PG8_LAS unsigned*)(lds + (bufoff) + ldsw + _i * 8192), 16, 0, 0); } while (0)
#define PG8_LDA(dst, b, h) do { _Pragma("unroll") for (int m = 0; m < 4; ++m) _Pragma("unroll") for (int k = 0; k < 2; ++k) dst[m][k] = *(const PG8_LAS bf16x8*)(lds + PG8_SA(b, h) + aoff + m * 2048 + k * 1024); } while (0)
#define PG8_LDB(dst, b, h) do { _Pragma("unroll") for (int n = 0; n < 2; ++n) _Pragma("unroll") for (int k = 0; k < 2; ++k) dst[n][k] = *(const PG8_LAS bf16x8*)(lds + PG8_SB(b, h) + boff + n * 2048 + k * 1024); } while (0)
#define PG8_MMA(ai, bj, At, Bt) do { __builtin_amdgcn_s_setprio(1); _Pragma("unroll") for (int m = 0; m < 4; ++m) _Pragma("unroll") for (int n = 0; n < 2; ++n) _Pragma("unroll") for (int k = 0; k < 2; ++k) \
        acc[ai][bj][m][n] = __builtin_amdgcn_mfma_f32_16x16x32_bf16(Bt[n][k], At[m][k], acc[ai][bj][m][n], 0, 0, 0); __builtin_amdgcn_s_setprio(0); } while (0)
#define PG8_WAIT_V(n) asm volatile("s_waitcnt vmcnt(" #n ")" ::: "memory")
#define PG8_WAIT_L(n) asm volatile("s_waitcnt lgkmcnt(" #n ")" ::: "memory")
#define PG8_BAR __builtin_amdgcn_s_barrier()
#define PG8_SCHED __builtin_amdgcn_sched_barrier(0)
    Unit cur, nxt; int ui = 0;
    if (!S.next(0, cur)) return;
    f32x4 acc[2][2][4][2];
#pragma unroll
    for (int a = 0; a < 2; ++a)
#pragma unroll
        for (int b = 0; b < 2; ++b)
#pragma unroll
            for (int m = 0; m < 4; ++m)
#pragma unroll
                for (int n = 0; n < 2; ++n) acc[a][b][m][n] = (f32x4){0.f, 0.f, 0.f, 0.f};
    bf16x8 At[4][2], B0[2][2], B1[2][2];
    const char* cA = (const char*)g.A + (size_t)cur.pm * tstep; const char* cB = (const char*)g.Bt + (size_t)cur.pn * tstep;
    S.a_ready(cur);
    static_assert(!PREB || SP2, "PREB is written for the SP2 loop");
    if constexpr (PREB) {
        PG8_STAGE(PG8_SA(0, 0), cA, voffA); PG8_STAGE(PG8_SA(0, 1), cA + hstep, voffA); PG8_STAGE(PG8_SA(1, 0), cA + kstep, voffA);
        if constexpr (HasPre<Epi>::v) E.pre();
        if (wr == 1) PG8_BAR;
        PG8_WAIT_V(4); PG8_BAR;
        PG8_WAIT_V(2); PG8_BAR;
    } else
    if constexpr (SP2) {
        PG8_STAGE(PG8_SB(0, 0), cB, voffB); PG8_STAGE(PG8_SB(0, 1), cB + hstep, voffB); PG8_STAGE(PG8_SA(0, 0), cA, voffA); PG8_STAGE(PG8_SA(0, 1), cA + hstep, voffA);
        PG8_STAGE(PG8_SB(1, 0), cB + kstep, voffB); PG8_STAGE(PG8_SA(1, 0), cA + kstep, voffA); PG8_STAGE(PG8_SB(1, 1), cB + hstep + kstep, voffB);
        if constexpr (HasPre<Epi>::v) E.pre();
        if (wr == 1) PG8_BAR;
        PG8_WAIT_V(8); PG8_BAR;
        PG8_WAIT_V(6); PG8_BAR;
    } else {
        PG8_STAGE(PG8_SB(0, 0), cB, voffB); PG8_STAGE(PG8_SA(0, 0), cA, voffA); PG8_STAGE(PG8_SB(0, 1), cB + hstep, voffB); PG8_STAGE(PG8_SA(0, 1), cA + hstep, voffA);
        if (wr == 1) PG8_BAR;
        PG8_WAIT_V(4); PG8_BAR;
        PG8_STAGE(PG8_SB(1, 0), cB + kstep, voffB); PG8_STAGE(PG8_SA(1, 0), cA + kstep, voffA); PG8_STAGE(PG8_SB(1, 1), cB + hstep + kstep, voffB);
        PG8_WAIT_V(6); PG8_BAR;
    }
    for (;;) {
        const bool has_next = S.next(ui + 1, nxt);
        const char* nA = has_next ? (const char*)g.A + (size_t)nxt.pm * tstep : cA; const char* nB = has_next ? (const char*)g.Bt + (size_t)nxt.pn * tstep : cB;
        for (int t = 0; t < nt; t += 2) {
            const bool last = (t == nt - 2);
            const char* a1 = cA + (size_t)(t + 1) * kstep;
            const char* a2 = last ? nA : cA + (size_t)(t + 2) * kstep; const char* b2 = last ? nB : cB + (size_t)(t + 2) * kstep;
            const char* a3 = a2 + kstep; const char* b3 = b2 + kstep;
            if (last && has_next) S.a_ready(nxt);
            if constexpr (SP2) {
            PG8_LDB(B0, 0, 0); PG8_LDB(B1, 0, 1); PG8_SCHED; PG8_LDA(At, 0, 0); PG8_STAGE(PG8_SA(1, 1), a1 + hstep, voffA);
            PG8_WAIT_V(8); PG8_WAIT_L(0); PG8_BAR; PG8_MMA(0, 0, At, B0); PG8_MMA(0, 1, At, B1); PG8_BAR; PG8_SCHED;
            PG8_LDA(At, 0, 1); PG8_STAGE(PG8_SB(0, 0), b2, voffB); PG8_STAGE(PG8_SB(0, 1), b2 + hstep, voffB); PG8_STAGE(PG8_SA(0, 0), a2, voffA);
            PG8_WAIT_V(8); PG8_WAIT_L(0); PG8_BAR; PG8_MMA(1, 0, At, B0); PG8_MMA(1, 1, At, B1); PG8_BAR; PG8_SCHED;
            PG8_LDB(B0, 1, 0); PG8_LDB(B1, 1, 1); PG8_SCHED; PG8_LDA(At, 1, 0); PG8_STAGE(PG8_SA(0, 1), a2 + hstep, voffA);
            PG8_WAIT_V(8); PG8_WAIT_L(0); PG8_BAR; PG8_MMA(0, 0, At, B0); PG8_MMA(0, 1, At, B1); PG8_BAR; PG8_SCHED;
            PG8_LDA(At, 1, 1); PG8_STAGE(PG8_SB(1, 0), b3, voffB); PG8_STAGE(PG8_SB(1, 1), b3 + hstep, voffB); PG8_STAGE(PG8_SA(1, 0), a3, voffA);
            PG8_WAIT_V(8); PG8_WAIT_L(0); PG8_BAR; PG8_MMA(1, 0, At, B0); PG8_MMA(1, 1, At, B1); PG8_BAR; PG8_SCHED;
            } else {
            PG8_LDB(B0, 0, 0); PG8_SCHED; PG8_LDA(At, 0, 0); PG8_STAGE(PG8_SA(1, 1), a1 + hstep, voffA);
            PG8_WAIT_L(8); PG8_BAR; PG8_WAIT_L(0); PG8_MMA(0, 0, At, B0); PG8_BAR; PG8_SCHED;
            PG8_LDB(B1, 0, 1); PG8_STAGE(PG8_SB(0, 0), b2, voffB);
            PG8_BAR; PG8_WAIT_L(0); PG8_MMA(0, 1, At, B1); PG8_BAR;
            PG8_LDA(At, 0, 1); PG8_STAGE(PG8_SA(0, 0), a2, voffA);
            PG8_BAR; PG8_WAIT_L(0); PG8_MMA(1, 0, At, B0); PG8_BAR; PG8_SCHED;
            PG8_STAGE(PG8_SB(0, 1), b2 + hstep, voffB);
            PG8_WAIT_V(6); PG8_BAR; PG8_MMA(1, 1, At, B1); PG8_BAR;
            PG8_LDB(B0, 1, 0); PG8_SCHED; PG8_LDA(At, 1, 0); PG8_STAGE(PG8_SA(0, 1), a2 + hstep, voffA);
            PG8_WAIT_L(8); PG8_BAR; PG8_WAIT_L(0); PG8_MMA(0, 0, At, B0); PG8_BAR; PG8_SCHED;
            PG8_LDB(B1, 1, 1); PG8_STAGE(PG8_SB(1, 0), b3, voffB);
            PG8_BAR; PG8_WAIT_L(0); PG8_MMA(0, 1, At, B1); PG8_BAR;
            PG8_LDA(At, 1, 1); PG8_STAGE(PG8_SA(1, 0), a3, voffA);
            PG8_BAR; PG8_WAIT_L(0); PG8_MMA(1, 0, At, B0); PG8_BAR; PG8_SCHED;
            PG8_STAGE(PG8_SB(1, 1), b3 + hstep, voffB);
            PG8_WAIT_V(6); PG8_BAR; PG8_MMA(1, 1, At, B1); PG8_BAR;
            }
        }
        if constexpr (ALIGN_EPI) { if (wr == 0) PG8_BAR; }
        if constexpr (!Epi::AFTER_DRAIN) { E(acc, cur, wr, wc, fr, fq); S.done(cur); }
        if (!has_next) break;
#pragma unroll
        for (int a = 0; a < 2; ++a)
#pragma unroll
            for (int b = 0; b < 2; ++b)
#pragma unroll
                for (int m = 0; m < 4; ++m)
#pragma unroll
                    for (int n = 0; n < 2; ++n) acc[a][b][m][n] = (f32x4){0.f, 0.f, 0.f, 0.f};
        cur = nxt; cA = nA; cB = nB; ++ui;
        if constexpr (ALIGN_EPI) { if (wr == 1) PG8_BAR; }
    }
    PG8_WAIT_V(0);
    if constexpr (!ALIGN_EPI) { if (wr == 0) PG8_BAR; }
    PG8_BAR;
    if constexpr (Epi::AFTER_DRAIN) { E.fused(acc, cur, wr, wc, fr, fq, lds, wid, lane); S.done(cur); }
#undef PG8_SA
#undef PG8_SB
#undef PG8_STAGE
#undef PG8_LDA
#undef PG8_LDB
#undef PG8_MMA
#undef PG8_WAIT_V
#undef PG8_WAIT_L
#undef PG8_BAR
#undef PG8_SCHED
}
}
#define GAS __attribute__((address_space(1)))
#define LAS __attribute__((address_space(3)))
typedef unsigned short bf16;
typedef unsigned v4u __attribute__((ext_vector_type(4)));
typedef float f32x4 __attribute__((ext_vector_type(4)));
typedef short bf16x8 __attribute__((ext_vector_type(8)));
typedef GAS unsigned gu32;
typedef GAS unsigned long long gu64;
#define RLX_AGENT __ATOMIC_RELAXED, __HIP_MEMORY_SCOPE_AGENT
#define LDS_WAIT() asm volatile("s_waitcnt lgkmcnt(0)" ::: "memory")
#define VM_WAIT() asm volatile("s_waitcnt vmcnt(0)" ::: "memory")
__device__ __forceinline__ unsigned long long rt() { return __builtin_amdgcn_s_memrealtime(); }
__device__ __forceinline__ unsigned f2bf(float f) { unsigned u = __builtin_bit_cast(unsigned, f); return (u + 0x7fffu + ((u >> 16) & 1u)) >> 16; }
typedef float f32x2_t __attribute__((ext_vector_type(2)));
typedef __bf16 bf16x2_t __attribute__((ext_vector_type(2)));
__device__ __forceinline__ unsigned pk2(float lo, float hi) { return __builtin_bit_cast(unsigned, __builtin_convertvector((f32x2_t){lo, hi}, bf16x2_t)); }
#define XB_TMO      128
#define XB_XCNT(j)  (256  + 64 * (j))
#define XB_XSUB(j)  (1280 + 64 * (j))
#define XB_XGEN(j)  (2304 + 64 * (j))
#define XB_TOP      3328
#define XB_TOPGEN   3392
#define XCD_BAR_WORDS 3456
#define XB_SPIN_CAP (1u << 18)

__device__ __forceinline__ unsigned xb_ld(unsigned* p)              { return __hip_atomic_load(p, __ATOMIC_RELAXED, __HIP_MEMORY_SCOPE_AGENT); }
__device__ __forceinline__ unsigned xb_add(unsigned* p, unsigned v) { return __hip_atomic_fetch_add(p, v, __ATOMIC_RELAXED, __HIP_MEMORY_SCOPE_AGENT); }
__device__ __forceinline__ unsigned xb_xcc_id() { return (unsigned)__builtin_amdgcn_s_getreg((3 << 11) | 20) & 0xFu; }
#define XB_SPIN(cond, bar) do { unsigned _sp = 0; while (cond) { __builtin_amdgcn_s_sleep(1); \
    if ((++_sp & 255u) == 0u) { if (xb_ld(&(bar)[XB_TMO])) break; if (_sp > XB_SPIN_CAP) { atomicAdd(&(bar)[XB_TMO], 1u); break; } } } } while (0)

struct XcdBarrier {
    unsigned* bar; unsigned x;
    volatile LAS unsigned* st;
    unsigned G;
};

__device__ __forceinline__ XcdBarrier xcd_barrier_post(unsigned* bar, volatile LAS unsigned* st) {
    XcdBarrier b; b.bar = bar; b.x = xb_xcc_id(); b.st = st; b.G = 0u;
    if (threadIdx.x == 0) (void)xb_add(&bar[XB_XCNT(b.x)], 1u);
    return b;
}
__device__ __forceinline__ void xcd_barrier_complete(unsigned* bar, unsigned x, unsigned G, unsigned& nloc, unsigned& nx) {
    unsigned sum, cnt, mine, sp = 0u;
    for (;;) {
        sum = 0u; cnt = 0u; mine = 0u;
#pragma unroll
        for (unsigned j = 0; j < 16; ++j) { const unsigned c = xb_ld(&bar[XB_XCNT(j)]); sum += c; cnt += (c > 0u) ? 1u : 0u; mine = (j == x) ? c : mine; }
        if (sum == G) break;
        __builtin_amdgcn_s_sleep(1);
        if ((++sp & 255u) == 0u) { if (xb_ld(&bar[XB_TMO])) break; if (sp > XB_SPIN_CAP) { atomicAdd(&bar[XB_TMO], 1u); break; } }
    }
    nloc = mine > 0u ? mine : 1u; nx = cnt > 0u ? cnt : 1u;
}

__device__ __forceinline__ void xcd_barrier(const XcdBarrier& b) {
    asm volatile("s_waitcnt vmcnt(0)" ::: "memory");
    __syncthreads();
    if (threadIdx.x == 0) {
        unsigned* bar = b.bar;
        __builtin_amdgcn_s_waitcnt(0);
        unsigned nloc = b.st[0], nx = b.st[1];
        if (nloc == 0u) { xcd_barrier_complete(bar, b.x, b.G, nloc, nx); b.st[0] = nloc; b.st[1] = nx; }
        const unsigned old = xb_add(&bar[XB_XSUB(b.x)], 1u);
        const unsigned gen = old / nloc;
        if (old + 1u == (gen + 1u) * nloc) {
            if (nx > 1u)
            __builtin_amdgcn_fence(__ATOMIC_RELEASE, "agent");
            asm volatile("s_waitcnt vmcnt(0)" ::: "memory");
            if (nx > 1u) {
            const unsigned og = xb_add(&bar[XB_TOP], 1u);
            const unsigned tg = og / nx;
            if (og + 1u == (tg + 1u) * nx) xb_add(&bar[XB_TOPGEN], 1u);
            else XB_SPIN(xb_ld(&bar[XB_TOPGEN]) == tg, bar);
            }
            __builtin_amdgcn_fence(__ATOMIC_ACQUIRE, "agent");
            xb_add(&bar[XB_XGEN(b.x)], 1u);
            asm volatile("s_waitcnt vmcnt(0)" ::: "memory");
        } else {
            XB_SPIN(xb_ld(&bar[XB_XGEN(b.x)]) == gen, bar);
            __builtin_amdgcn_fence(__ATOMIC_ACQUIRE, "agent");
            asm volatile("s_waitcnt vmcnt(0)" ::: "memory");
        }
    }
    __syncthreads();
}

__device__ __forceinline__ void xcd_barrier_arrive(const XcdBarrier& b, unsigned& old, unsigned& nloc, unsigned& nx) {
    asm volatile("s_waitcnt vmcnt(0)" ::: "memory");
    __syncthreads();
    if (threadIdx.x == 0) {
        unsigned* bar = b.bar;
        __builtin_amdgcn_s_waitcnt(0);
        nloc = b.st[0]; nx = b.st[1];
        if (nloc == 0u) { xcd_barrier_complete(bar, b.x, b.G, nloc, nx); b.st[0] = nloc; b.st[1] = nx; }
        old = xb_add(&bar[XB_XSUB(b.x)], 1u);
        if (nx == 1u) { const unsigned gen = old / nloc; if (old + 1u == (gen + 1u) * nloc) (void)xb_add(&bar[XB_XGEN(b.x)], 1u); }
    }
}
__device__ __forceinline__ void xcd_barrier_finish(const XcdBarrier& b, unsigned old, unsigned nloc, unsigned nx) {
    if (threadIdx.x == 0) {
        unsigned* bar = b.bar;
        const unsigned gen = old / nloc;
        if (old + 1u == (gen + 1u) * nloc) {
            if (nx > 1u) {
                __builtin_amdgcn_fence(__ATOMIC_RELEASE, "agent");
                asm volatile("s_waitcnt vmcnt(0)" ::: "memory");
                const unsigned og = xb_add(&bar[XB_TOP], 1u);
                const unsigned tg = og / nx;
                if (og + 1u == (tg + 1u) * nx) xb_add(&bar[XB_TOPGEN], 1u);
                else XB_SPIN(xb_ld(&bar[XB_TOPGEN]) == tg, bar);
                __builtin_amdgcn_fence(__ATOMIC_ACQUIRE, "agent");
                xb_add(&bar[XB_XGEN(b.x)], 1u);
            } else {
                __builtin_amdgcn_fence(__ATOMIC_ACQUIRE, "agent");
            }
            asm volatile("s_waitcnt vmcnt(0)" ::: "memory");
        } else {
            XB_SPIN(xb_ld(&bar[XB_XGEN(b.x)]) == gen, bar);
            __builtin_amdgcn_fence(__ATOMIC_ACQUIRE, "agent");
            asm volatile("s_waitcnt vmcnt(0)" ::: "memory");
        }
    }
    __syncthreads();
}

__device__ __forceinline__ void xcd_barrier_arrive_top(const XcdBarrier& b, unsigned& old, unsigned& nloc, unsigned& nx, unsigned& og) {
    asm volatile("s_waitcnt vmcnt(0)" ::: "memory");
    __syncthreads();
    if (threadIdx.x == 0) {
        unsigned* bar = b.bar;
        __builtin_amdgcn_s_waitcnt(0);
        nloc = b.st[0]; nx = b.st[1];
        if (nloc == 0u) { xcd_barrier_complete(bar, b.x, b.G, nloc, nx); b.st[0] = nloc; b.st[1] = nx; }
        old = xb_add(&bar[XB_XSUB(b.x)], 1u);
        const unsigned gen = old / nloc;
        if (old + 1u == (gen + 1u) * nloc) {
            if (nx > 1u) {
                __builtin_amdgcn_fence(__ATOMIC_RELEASE, "agent");
                asm volatile("s_waitcnt vmcnt(0)" ::: "memory");
                og = xb_add(&bar[XB_TOP], 1u);
                const unsigned tg = og / nx;
                if (og + 1u == (tg + 1u) * nx) (void)xb_add(&bar[XB_TOPGEN], 1u);
            } else (void)xb_add(&bar[XB_XGEN(b.x)], 1u);
        }
    }
}
__device__ __forceinline__ void xcd_barrier_finish_top(const XcdBarrier& b, unsigned old, unsigned nloc, unsigned nx, unsigned og) {
    if (threadIdx.x == 0) {
        unsigned* bar = b.bar;
        const unsigned gen = old / nloc;
        if (old + 1u == (gen + 1u) * nloc) {
            if (nx > 1u) {
                const unsigned tg = og / nx;
                XB_SPIN(xb_ld(&bar[XB_TOPGEN]) == tg, bar);
                __builtin_amdgcn_fence(__ATOMIC_ACQUIRE, "agent");
                (void)xb_add(&bar[XB_XGEN(b.x)], 1u);
            } else {
                __builtin_amdgcn_fence(__ATOMIC_ACQUIRE, "agent");
            }
            asm volatile("s_waitcnt vmcnt(0)" ::: "memory");
        } else {
            XB_SPIN(xb_ld(&bar[XB_XGEN(b.x)]) == gen, bar);
            __builtin_amdgcn_fence(__ATOMIC_ACQUIRE, "agent");
            asm volatile("s_waitcnt vmcnt(0)" ::: "memory");
        }
    }
    __syncthreads();
}
constexpr int DM = 1024, NB = 16, SEQ = 2048, M = NB * SEQ, DEPTH = 2;
constexpr int NPROJ = 2560, INCOLS = 2564, DFF = 2816, NGU = 2 * DFF;
constexpr float EPS = 1e-6f;
constexpr size_t MiB = 1u << 20;
constexpr size_t WS_CTL = 0, CTL_ZERO_BYTES = MiB / 4;
constexpr size_t WS_WIN = 2 * MiB, WS_WOUT = 12 * MiB, WS_WGU = 16 * MiB, WS_WDN = 38 * MiB;
constexpr size_t WS_DT = 49 * MiB, WS_PW = 50 * MiB, WS_SW = 51 * MiB, WS_DEC = 52 * MiB, WS_WDT = 53 * MiB;
constexpr size_t WS_HB = 64 * MiB;
constexpr size_t WS_ACT = 128 * MiB;
constexpr size_t WS_ST = 352 * MiB, WS_PV = 416 * MiB;
constexpr size_t WS_SSQ = 448 * MiB, WS_DTP = 460 * MiB, WS_END = 468 * MiB;
#ifndef NGROUPS
#define NGROUPS 8
#endif
#ifndef SKEW_US
#define SKEW_US 0
#endif
#ifndef STAG_G1
#define STAG_G1 0
#endif
#ifndef STAG_G3
#define STAG_G3 0
#endif
constexpr int MG = M / NGROUPS;
constexpr size_t ACT_GROUP_BYTES = (size_t)MG * (NPROJ + DM) * 2;
static_assert((size_t)MG * DFF * 2 <= ACT_GROUP_BYTES && WS_ACT + NGROUPS * ACT_GROUP_BYTES <= WS_ST, "activation blocks");
static_assert(P_STRIDE == M, "P_STRIDE");
constexpr int NWAVES = 8;
constexpr int RING_BYTES = 131072, LDS_BYTES = 163840, LDSCTL_OFF = LDS_BYTES - 512, MISC_OFF = LDSCTL_OFF + 320;
constexpr int CW_BAR = 4096;
constexpr int CW_FIN = 40960;
static_assert(CW_BAR + 9 * 3456 <= CW_FIN && (size_t)(CW_FIN + 128 * 64) * 4 <= CTL_ZERO_BYTES, "control words inside the per-call memset");
#ifndef FUSE_FINAL
#define FUSE_FINAL 1
#endif
constexpr int RT_OFF = RING_BYTES + 64;
#ifndef REP_M1
#define REP_M1 1
#endif
#ifndef REP_POOL
#define REP_POOL 1
#endif
#ifndef REP_SGU
#define REP_SGU 1
#endif
#ifndef REP_SCONV
#define REP_SCONV 1
#endif
#ifndef REP_SCAN
#define REP_SCAN 1
#endif
#ifndef REP_SSDOUT
#define REP_SSDOUT 1
#endif
#ifndef REP_G1
#define REP_G1 1
#endif
#ifndef REP_G3
#define REP_G3 1
#endif
#ifndef REP_BAR
#define REP_BAR 1
#endif
#ifndef PROBE_G2
#define PROBE_G2 0
#endif
#ifndef PROBE_G4
#define PROBE_G4 0
#endif
#ifndef REP_P0
#define REP_P0 1
#endif
#ifndef REP_XPASS
#define REP_XPASS 1
#endif
#ifndef TSLOT
#define TSLOT -1
#endif
#ifndef TRANS_NT
#define TRANS_NT 1
#endif
#ifndef XPASS_NT
#define XPASS_NT 1
#endif
#ifndef P0_SHADOW
#define P0_SHADOW 1
#endif
#ifndef MIX_SHADOW
#define MIX_SHADOW 1
#endif
#ifndef TBLK
#define TBLK 0
#endif
#ifndef TQUANT
#define TQUANT 0
#endif
#ifndef PROBE_KLOOP
#define PROBE_KLOOP 0
#endif
#ifndef CQ
#define CQ 50ull
#endif
#ifndef SSD_SKIP
#define SSD_SKIP 0
#endif
#ifndef GEMM_ALIGN
#define GEMM_ALIGN true
#endif
#ifndef GEMM_SP2
#define GEMM_SP2 true
#endif
#ifndef G2_NULL
#define G2_NULL 0
#endif
#ifndef GROUP_SPREAD
#define GROUP_SPREAD 0
#endif
#ifndef PROBE_NOP
#define PROBE_NOP 0
#endif
__device__ __forceinline__ float bf2f(bf16 u) { return __builtin_bit_cast(float, (unsigned)u << 16); }
__device__ __forceinline__ float wave_sum(float v) {
    v += dpp_f<0xB1>(v); v += dpp_f<0x4E>(v); v += dpp_f<0x141>(v); v += dpp_f<0x140>(v); v += lane_xor<16>(v); v = add_xor32(v);
    return v;
}
__device__ __forceinline__ float fexp(float x) { return __builtin_amdgcn_exp2f(x * 1.4426950408889634f); }
__device__ __forceinline__ float frsq(float x) { return __builtin_amdgcn_rsqf(x); }
__device__ __forceinline__ float frcp(float x) { return __builtin_amdgcn_rcpf(x); }

__device__ __forceinline__ int fresh_tid() { int t = threadIdx.x; asm volatile("" : "+v"(t)); return t; }
struct Args { const float* in[23]; float* out; unsigned char* ws; };
struct Frame { LAS unsigned char* lds; volatile LAS unsigned* MISC; gu32* ctl; int wave;
               int bid, vcu, G;
               int gbid, gvcu, GG; };

__device__ __forceinline__ void p_transpose(Frame& F, const float* W, int K, int ldn, int nblk, bf16* WT, int mode, const float* gk) {
    LAS float* scr = (LAS float*)(F.lds + F.wave * 16384);
    const int gw = F.gvcu * NWAVES + F.wave, NGW = F.GG * NWAVES, lane = fresh_tid() & 63;
    const int nitems = (K / 64) * nblk;
    for (int item = gw; item < nitems; item += NGW) {
        const int kb = item / nblk, nb = item % nblk, k0 = 64 * kb, n0 = 32 * nb;
        const float* src = W + (size_t)(k0 + (lane >> 5)) * ldn + n0 + (lane & 31);
        float r[32];
#pragma unroll
        for (int i = 0; i < 32; ++i) r[i] = TRANS_NT ? __builtin_nontemporal_load((const GAS float*)src + (size_t)(2 * i) * ldn) : src[(size_t)(2 * i) * ldn];
        const int c = lane & 7;
        f32x4 g0 = {1.f, 1.f, 1.f, 1.f}, g1 = {1.f, 1.f, 1.f, 1.f};
        if (gk) { g0 = *(const GAS f32x4*)(gk + k0 + 8 * c); g1 = *(const GAS f32x4*)(gk + k0 + 8 * c + 4); }
#pragma unroll
        for (int i = 0; i < 32; ++i) scr[(2 * i + (lane >> 5)) * 33 + (lane & 31)] = r[i];
        LDS_WAIT(); asm volatile("" ::: "memory");
#pragma unroll
        for (int j = 0; j < 4; ++j) { const int n = (lane >> 3) + 8 * j; const LAS float* s = scr + (8 * c) * 33 + n;
            v4u o; o.x = pk2(s[0 * 33] * g0.x, s[1 * 33] * g0.y); o.y = pk2(s[2 * 33] * g0.z, s[3 * 33] * g0.w); o.z = pk2(s[4 * 33] * g1.x, s[5 * 33] * g1.y); o.w = pk2(s[6 * 33] * g1.z, s[7 * 33] * g1.w);
            const int ng = n0 + n; const int drow = (mode == 0) ? ng : (((ng >> 7) << 8) + (mode == 2 ? 128 : 0) + (ng & 127));
            *(GAS v4u*)(WT + (size_t)drow * K + k0 + 8 * c) = o; }
        LDS_WAIT(); asm volatile("" ::: "memory");
    }
}
__device__ __forceinline__ void p_xpass(Frame& F, const float* x, const float* g, const float* wdt, bf16* hb, float* P, float* dt) {
    const int lane = fresh_tid() & 63;
    const int gw = F.vcu * NWAVES + F.wave, NGW = F.G * NWAVES;
    LAS f32x4* wl = (LAS f32x4*)F.lds;
    __syncthreads();
    for (int i = fresh_tid(); i < DM; i += NWAVES * 64) wl[(i & 7) * 128 + (i >> 3)] = *(const GAS f32x4*)(wdt + (size_t)i * INCOLS) * g[i];
    __syncthreads();
    for (int row = gw; row < MG; row += NGW) {
        const GAS f32x4* hr = (const GAS f32x4*)(x + (size_t)row * DM) + 2 * lane;
        f32x4 v[4]; float s = 0.f;
#pragma unroll
        for (int j = 0; j < 4; ++j) { v[j] = XPASS_NT ? __builtin_nontemporal_load(hr + 128 * (j >> 1) + (j & 1)) : hr[128 * (j >> 1) + (j & 1)]; s += (v[j].x * v[j].x + v[j].y * v[j].y) + (v[j].z * v[j].z + v[j].w * v[j].w); }
        s = wave_sum(s);
        const float rstd = frsq(s * (1.0f / DM) + EPS);
        GAS v4u* o16 = (GAS v4u*)(hb + (size_t)row * DM) + lane;
        f32x4 d = {0.f, 0.f, 0.f, 0.f};
#pragma unroll
        for (int jj = 0; jj < 2; ++jj) { const f32x4 y0 = v[2 * jj], y1 = v[2 * jj + 1];
            v4u o; o.x = pk2(y0.x, y0.y); o.y = pk2(y0.z, y0.w); o.z = pk2(y1.x, y1.y); o.w = pk2(y1.z, y1.w); o16[64 * jj] = o;
            const int kq = lane + 64 * jj;
#pragma unroll
            for (int e = 0; e < 4; ++e) { d += y0[e] * wl[e * 128 + kq]; d += y1[e] * wl[(4 + e) * 128 + kq]; } }
        d.x = wave_sum(d.x); d.y = wave_sum(d.y); d.z = wave_sum(d.z); d.w = wave_sum(d.w);
        if (lane == 0) *(GAS f32x4*)(dt + (size_t)row * 4) = d * rstd;
        if (lane < 16) P[(size_t)lane * P_STRIDE + row] = s * (1.0f / 16.0f);
    }
    __syncthreads();
}

typedef unsigned u32x2 __attribute__((ext_vector_type(2)));
__device__ __forceinline__ f32x4 mfma16(bf16x8 first, bf16x8 second, f32x4 c) { return __builtin_amdgcn_mfma_f32_16x16x32_bf16(first, second, c, 0, 0, 0); }
__device__ __forceinline__ float bfe(bf16x8 v, int e) { return __builtin_bit_cast(float, (unsigned)(unsigned short)v[e] << 16); }
__device__ __forceinline__ bf16x8 pack8(const float (&f)[8]) { v4u o; o.x = pk2(f[0], f[1]); o.y = pk2(f[2], f[3]); o.z = pk2(f[4], f[5]); o.w = pk2(f[6], f[7]); return __builtin_bit_cast(bf16x8, o); }
__device__ __forceinline__ u32x2 pack4(f32x4 f) { u32x2 o; o.x = pk2(f.x, f.y); o.y = pk2(f.z, f.w); return o; }
__device__ __forceinline__ f32x4 unpack4(u32x2 u) { f32x4 f; f.x = __builtin_bit_cast(float, u.x << 16); f.y = __builtin_bit_cast(float, u.x & 0xffff0000u); f.z = __builtin_bit_cast(float, u.y << 16); f.w = __builtin_bit_cast(float, u.y & 0xffff0000u); return f; }
__device__ __forceinline__ float silu_fast(float x) { return x * __builtin_amdgcn_rcpf(1.0f + __builtin_amdgcn_exp2f(-1.4426950408889634f * x)); }
__device__ __forceinline__ float softplus_f(float x) { const float e = fexp(x); const float s = e * (1.0f - e * (0.5f - e * (0.33333334f - 0.25f * e))); const float b = __builtin_amdgcn_logf(1.0f + e) * 0.6931471805599453f; return x > 20.f ? x : (e < 0.03f ? s : b); }

__device__ __forceinline__ void p_finalnorm(Frame& F, const bf16* hb, float* out, const float* P, const float* g) {
    const int lane = fresh_tid() & 63;
    const int gw = F.vcu * NWAVES + F.wave, NGW = F.G * NWAVES;
    const GAS f32x4* gr = (const GAS f32x4*)g + 2 * lane;
    const f32x4 g0 = gr[0], g1 = gr[1], g2 = gr[128], g3 = gr[129];
    for (int row0 = 4 * gw; row0 < MG; row0 += 4 * NGW) {
        float s = P[(size_t)(lane & 15) * P_STRIDE + row0 + (lane >> 4)];
        v4u a[4], b[4];
#pragma unroll
        for (int r = 0; r < 4; ++r) { a[r] = *(const GAS v4u*)(hb + (size_t)(row0 + r) * DM + 8 * lane); b[r] = *(const GAS v4u*)(hb + (size_t)(row0 + r) * DM + 512 + 8 * lane); }
        s += lane_xor<1>(s); s += lane_xor<2>(s); s += lane_xor<4>(s); s += lane_xor<8>(s);
        const float rsl = frsq(s * (1.0f / DM) + EPS);
#pragma unroll
        for (int r = 0; r < 4; ++r) { const float rstd = __builtin_bit_cast(float, __builtin_amdgcn_readlane(__builtin_bit_cast(int, rsl), 16 * r));
            GAS f32x4* o = (GAS f32x4*)(out + (size_t)(row0 + r) * DM) + 2 * lane;
            o[0] = unpack4((u32x2){a[r].x, a[r].y}) * rstd * g0; o[1] = unpack4((u32x2){a[r].z, a[r].w}) * rstd * g1;
            o[128] = unpack4((u32x2){b[r].x, b[r].y}) * rstd * g2; o[129] = unpack4((u32x2){b[r].z, b[r].w}) * rstd * g3; }
    }
}

__device__ __forceinline__ void p_small_weights(Frame& F, const float* pw, bf16* pwT, const float* sw, bf16* swm) {
    const int tid = fresh_tid();
    for (int idx = F.gbid * 512 + tid; idx < 4 * 64 * 64; idx += F.GG * 512) { const int g = idx >> 12, d = (idx >> 6) & 63, c = idx & 63; pwT[idx] = (bf16)f2bf(pw[(g * 64 + c) * 64 + d]); }
    for (int idx = F.gbid * 512 + tid; idx < 4 * 128 * 128; idx += F.GG * 512) { const int i = (idx >> 7) & 127, j = idx & 127; swm[idx] = (i < 64 && j >= 64) ? (bf16)0 : (bf16)f2bf(sw[idx]); }
}

__device__ __forceinline__ bf16x8 row_or_zero(const bf16* p, int trel) {
    const int fix = trel < 0 ? -trel : 0; const v4u v = *(const GAS v4u*)(p + (ptrdiff_t)fix * NPROJ); const unsigned m = trel < 0 ? 0u : 0xffffffffu;
    return __builtin_bit_cast(bf16x8, (v4u){v.x & m, v.y & m, v.z & m, v.w & m});
}
__device__ __forceinline__ int prow32(int nt, int fr) { return 32 * (nt >> 1) + 8 * (fr >> 2) + 4 * (nt & 1) + (fr & 3); }
__device__ __forceinline__ bf16x8 pack8v(f32x4 a, f32x4 b) { v4u o; o.x = pk2(a.x, a.y); o.y = pk2(a.z, a.w); o.z = pk2(b.x, b.y); o.w = pk2(b.z, b.w); return __builtin_bit_cast(bf16x8, o); }
template <int WIN> __device__ __forceinline__ void pool_run(const bf16* col, int ts0, LAS bf16* dst, int ldp) {
    bf16x8 R[WIN + 7];
#pragma unroll
    for (int j = 0; j < WIN + 7; ++j) R[j] = row_or_zero(col + (ptrdiff_t)(j - (WIN - 1)) * NPROJ, ts0 + j - (WIN - 1));
    float s[8];
#pragma unroll
    for (int e = 0; e < 8; ++e) s[e] = 0.f;
#pragma unroll
    for (int j = 0; j < WIN - 1; ++j)
#pragma unroll
        for (int e = 0; e < 8; ++e) s[e] += bfe(R[j], e);
#pragma unroll
    for (int i = 0; i < 8; ++i) { const int ts = ts0 + i; const int cnt = (ts + 1 < WIN) ? ts + 1 : WIN; const float inv = frcp((float)cnt); float o[8];
#pragma unroll
        for (int e = 0; e < 8; ++e) { s[e] += bfe(R[WIN - 1 + i], e); o[e] = s[e] * inv - bfe(R[WIN - 1 + i], e); }
        *(LAS bf16x8*)(dst + i * ldp) = pack8(o);
#pragma unroll
        for (int e = 0; e < 8; ++e) s[e] -= bfe(R[i], e); }
}
__device__ __forceinline__ void f_pool(Frame& F, const bf16* proj, const bf16* wT, const float* bias, const float* scale, bf16* mix) {
    LAS bf16* P = (LAS bf16*)F.lds; constexpr int LDP = 264;
    const int lane = fresh_tid() & 63, wave = F.wave;
    for (int tile = F.bid; tile < MG / 128; tile += F.G) {
        const int tok0 = tile * 128;
        bf16x8 wfr[2][4];
#pragma unroll
        for (int ks = 0; ks < 2; ++ks)
#pragma unroll
            for (int nt = 0; nt < 4; ++nt) wfr[ks][nt] = *(const GAS bf16x8*)((wT + ((wave >> 1) * 64) * 64 + 32 * ks) + prow32(nt, lane & 15) * 64 + 8 * (lane >> 4));
        {   const int g = wave & 3, cg = (lane & 7) + 8 * g, tr = (wave >> 2) * 8 + (lane >> 3), r0 = tr * 8;
            const int ts0 = (tok0 & (SEQ - 1)) + r0;
            const bf16* col = proj + (size_t)(tok0 + r0) * NPROJ + 8 * cg; LAS bf16* dst = P + r0 * LDP + 8 * cg;
            if (g == 0) pool_run<2>(col, ts0, dst, LDP); else if (g == 1) pool_run<4>(col, ts0, dst, LDP); else if (g == 2) pool_run<8>(col, ts0, dst, LDP); else pool_run<16>(col, ts0, dst, LDP);
        }
        __syncthreads();
        {   const int g = wave >> 1, th = wave & 1, fr = lane & 15, fq = lane >> 4;
            f32x4 acc[4][4];
#pragma unroll
            for (int a = 0; a < 4; ++a)
#pragma unroll
                for (int b = 0; b < 4; ++b) acc[a][b] = (f32x4){0.f, 0.f, 0.f, 0.f};
#pragma unroll
            for (int ks = 0; ks < 2; ++ks) { bf16x8 afr[4];
#pragma unroll
                for (int mt = 0; mt < 4; ++mt) afr[mt] = *(const LAS bf16x8*)(P + (64 * th + 16 * mt + fr) * LDP + 64 * g + 32 * ks + 8 * fq);
#pragma unroll
                for (int mt = 0; mt < 4; ++mt)
#pragma unroll
                    for (int nt = 0; nt < 4; ++nt) acc[mt][nt] = mfma16(wfr[ks][nt], afr[mt], acc[mt][nt]); }
#pragma unroll
            for (int a = 0; a < 2; ++a) { const int c = 64 * g + 32 * a + 8 * fq;
                const f32x4 bi0 = *(const GAS f32x4*)(bias + c), bi1 = *(const GAS f32x4*)(bias + c + 4), sc0 = *(const GAS f32x4*)(scale + c), sc1 = *(const GAS f32x4*)(scale + c + 4);
#pragma unroll
                for (int mt = 0; mt < 4; ++mt) { const int tok = tok0 + 64 * th + 16 * mt + fr;
                    *(GAS bf16x8*)(mix + (size_t)tok * DM + c) = pack8v((acc[mt][2 * a] + bi0) * sc0, (acc[mt][2 * a + 1] + bi1) * sc1); } }
        }
        __syncthreads();
    }
}

__device__ __forceinline__ void f_sconv(Frame& F, const bf16* proj, const float* w, bf16* mix) {
    for (int tile = F.bid; tile < MG / 128; tile += F.G) {
        const int tid_ = fresh_tid();
        const int tok0 = tile * 128, cg = tid_ & 31, tr = tid_ >> 5, r0 = 8 * tr, ts0 = (tok0 & (SEQ - 1)) + r0;
        const bf16* base = proj + (size_t)(tok0 + r0) * NPROJ + 8 * cg;
        float w0[8], w1[8], w2[8], pm2[8], pm1[8];
#pragma unroll
        for (int e = 0; e < 8; ++e) { w0[e] = w[8 * cg + e]; w1[e] = w[256 + 8 * cg + e]; w2[e] = w[512 + 8 * cg + e]; pm2[e] = 0.f; pm1[e] = 0.f; }
        { const bf16x8 a2 = row_or_zero(base - 2 * (ptrdiff_t)NPROJ + 1024, ts0 - 2), b2 = row_or_zero(base - 2 * (ptrdiff_t)NPROJ + 1280, ts0 - 2), a1 = row_or_zero(base - (ptrdiff_t)NPROJ + 1024, ts0 - 1), b1 = row_or_zero(base - (ptrdiff_t)NPROJ + 1280, ts0 - 1);
#pragma unroll
          for (int e = 0; e < 8; ++e) { pm2[e] = bfe(a2, e) * bfe(b2, e); pm1[e] = bfe(a1, e) * bfe(b1, e); } }
#pragma unroll
        for (int i = 0; i < 8; ++i) { const bf16* r = base + (ptrdiff_t)i * NPROJ;
            const bf16x8 cb = *(const GAS bf16x8*)(r + 768), cc = *(const GAS bf16x8*)(r + 1024), ch = *(const GAS bf16x8*)(r + 1280); float o[8];
#pragma unroll
            for (int e = 0; e < 8; ++e) { const float p = bfe(cc, e) * bfe(ch, e); o[e] = bfe(cb, e) * (w0[e] * pm2[e] + w1[e] * pm1[e] + w2[e] * p); pm2[e] = pm1[e]; pm1[e] = p; }
            *(GAS bf16x8*)(mix + (size_t)(tok0 + r0 + i) * DM + 512 + 8 * cg) = pack8(o); }
    }
}

__device__ __forceinline__ void f_sgu(Frame& F, const bf16* proj, const float* ln_g, const float* ln_b, const bf16* swm, const float* sb, bf16* mix) {
    LAS bf16* VT = (LAS bf16*)F.lds; constexpr int LDV = 136;
    const int lane = fresh_tid() & 63, wave = F.wave, fr = lane & 15, fq = lane >> 4;
    const int h = wave >> 1, cb0 = 64 * h + 32 * (wave & 1);
    const unsigned aoff = fr * 128 + 8 * fq, uoff = fr * NPROJ + 8 * fq, moff = fr * DM + 8 * fq;
    for (int tile = F.bid; tile < MG / 128; tile += F.G) {
        const int tok0 = tile * 128;
        u32x2 raw[16];
#pragma unroll
        for (int i = 0; i < 16; ++i) raw[i] = *(const GAS u32x2*)((proj + (size_t)(tok0 + 16 * wave + i) * NPROJ + 512) + 4 * lane);
        bf16x8 afr[4][8];
#pragma unroll
        for (int mt = 0; mt < 8; ++mt) afr[0][mt] = *(const GAS bf16x8*)((swm + (h * 128 + 16 * mt) * 128) + aoff);
        {   const f32x4 gv = *(const GAS f32x4*)(ln_g + 4 * lane), bv = *(const GAS f32x4*)(ln_b + 4 * lane);
#pragma unroll
            for (int bt = 0; bt < 2; ++bt) { const int t0 = 16 * wave + 8 * bt; f32x4 v[8]; float mu[8], rs[8];
#pragma unroll
                for (int i = 0; i < 8; ++i) v[i] = unpack4(raw[8 * bt + i]);
#pragma unroll
                for (int i = 0; i < 8; ++i) mu[i] = wave_sum((v[i].x + v[i].y) + (v[i].z + v[i].w)) * (1.0f / 256.0f);
#pragma unroll
                for (int i = 0; i < 8; ++i) { v[i] = v[i] - mu[i]; rs[i] = frsq(wave_sum((v[i].x * v[i].x + v[i].y * v[i].y) + (v[i].z * v[i].z + v[i].w * v[i].w)) * (1.0f / 256.0f) + EPS); }
#pragma unroll
                for (int e = 0; e < 4; ++e) { float o[8];
#pragma unroll
                    for (int i = 0; i < 8; ++i) o[i] = v[i][e] * rs[i] * gv[e] + bv[e];
                    *(LAS bf16x8*)(VT + (4 * lane + e) * LDV + t0) = pack8(o); } }
        }
        asm volatile("" ::: "memory");
#pragma unroll
        for (int mt = 0; mt < 8; ++mt) afr[1][mt] = *(const GAS bf16x8*)((swm + (h * 128 + 16 * mt) * 128 + 32) + aoff);
#pragma unroll
        for (int ks = 2; ks < 4; ++ks)
#pragma unroll
            for (int mt = 4; mt < 8; ++mt) afr[ks][mt] = *(const GAS bf16x8*)((swm + (h * 128 + 16 * mt) * 128 + 32 * ks) + aoff);
        v4u ur[8]; float bsv[8];
#pragma unroll
        for (int mt = 0; mt < 8; ++mt) { bsv[mt] = sb[h * 128 + 16 * mt + fr];
            ur[mt] = *(const GAS v4u*)((proj + (size_t)(tok0 + 16 * mt) * NPROJ + 256 + cb0) + uoff); }
        __syncthreads();
        {   f32x4 acc[8][2];
#pragma unroll
            for (int a = 0; a < 8; ++a) { acc[a][0] = (f32x4){0.f, 0.f, 0.f, 0.f}; acc[a][1] = (f32x4){0.f, 0.f, 0.f, 0.f}; }
#pragma unroll
            for (int ks = 0; ks < 4; ++ks) { bf16x8 bfr[2];
#pragma unroll
                for (int nt = 0; nt < 2; ++nt) bfr[nt] = *(const LAS bf16x8*)(VT + (cb0 + prow32(nt, fr)) * LDV + 32 * ks + 8 * fq);
#pragma unroll
                for (int mt = 0; mt < 8; ++mt) { if (ks >= 2 && mt < 4) continue;
                    acc[mt][0] = mfma16(bfr[0], afr[ks][mt], acc[mt][0]); acc[mt][1] = mfma16(bfr[1], afr[ks][mt], acc[mt][1]); } }
#pragma unroll
            for (int mt = 0; mt < 8; ++mt) { const v4u u = ur[mt];
                *(GAS bf16x8*)((mix + (size_t)(tok0 + 16 * mt) * DM + 256 + cb0) + moff) = pack8v(unpack4((u32x2){u.x, u.y}) * (acc[mt][0] + bsv[mt]), unpack4((u32x2){u.z, u.w}) * (acc[mt][1] + bsv[mt])); }
        }
        __syncthreads();
    }
}

__device__ __forceinline__ void ssd_stage_weights(const float* cw, const float* cb, LAS float* WL) {
    const int tid = fresh_tid();
    for (int i = tid; i < 768; i += NWAVES * 64) { *(LAS f32x4*)(WL + 4 * i) = *(const GAS f32x4*)(cw + 4 * i); }
    for (int i = tid; i < 192; i += NWAVES * 64) { *(LAS f32x4*)(WL + 3072 + 4 * i) = *(const GAS f32x4*)(cb + 4 * i); }
    __syncthreads();
}
__device__ __forceinline__ void ssd_rows11(const bf16* src, int ts0, bf16x8 (&R)[11]) {
#pragma unroll
    for (int k = 0; k < 11; ++k) R[k] = row_or_zero(src + (ptrdiff_t)(k - 3) * NPROJ, ts0 + k - 3);
}
typedef float f32x2m __attribute__((ext_vector_type(2)));
__device__ __forceinline__ f32x2m bf2pair(unsigned d) { return (f32x2m){__builtin_bit_cast(float, d << 16), __builtin_bit_cast(float, d & 0xffff0000u)}; }
__device__ __forceinline__ f32x2m silu2(f32x2m a) { const f32x2m t = a * -1.4426950408889634f; f32x2m e; e.x = __builtin_amdgcn_exp2f(t.x); e.y = __builtin_amdgcn_exp2f(t.y);
    const f32x2m d = e + 1.0f; f32x2m r; r.x = __builtin_amdgcn_rcpf(d.x); r.y = __builtin_amdgcn_rcpf(d.y); return a * r; }
template <int NT> __device__ __forceinline__ void ssd_conv8xN(const bf16x8 (&R)[NT + 3], const LAS float* cw, const LAS float* cb, float (&out)[NT][8]) {
    f32x4 wv[4][2], bv[2];
#pragma unroll
    for (int k = 0; k < 4; ++k) { wv[k][0] = *(const LAS f32x4*)(cw + k * 768); wv[k][1] = *(const LAS f32x4*)(cw + k * 768 + 4); }
    bv[0] = *(const LAS f32x4*)cb; bv[1] = *(const LAS f32x4*)(cb + 4);
#pragma unroll
    for (int ep = 0; ep < 4; ++ep) { f32x2m w2[4]; const f32x2m b2 = {bv[ep >> 1][2 * (ep & 1)], bv[ep >> 1][2 * (ep & 1) + 1]};
#pragma unroll
        for (int k = 0; k < 4; ++k) w2[k] = (f32x2m){wv[k][ep >> 1][2 * (ep & 1)], wv[k][ep >> 1][2 * (ep & 1) + 1]};
        f32x2m x2[NT + 3];
#pragma unroll
        for (int j = 0; j < NT + 3; ++j) x2[j] = bf2pair(__builtin_bit_cast(v4u, R[j])[ep]);
#pragma unroll
        for (int i = 0; i < NT; ++i) { f32x2m a2 = b2;
#pragma unroll
            for (int k = 0; k < 4; ++k) a2 += w2[k] * x2[i + k];
            const f32x2m s2 = silu2(a2); out[i][2 * ep] = s2.x; out[i][2 * ep + 1] = s2.y; } }
}
__device__ __forceinline__ void ssd_conv8x8(const bf16x8 (&R)[11], const LAS float* cw, const LAS float* cb, float (&out)[8][8]) { ssd_conv8xN<8>(R, cw, cb, out); }
__device__ __forceinline__ void ssd_conv8x4(const bf16x8 (&R)[7], const LAS float* cw, const LAS float* cb, float (&out)[4][8]) { ssd_conv8xN<4>(R, cw, cb, out); }
__device__ __forceinline__ void ssd_delta_acs(float dtv, int h, int lane, const float* dt_bias, const float* a_log, float& delta, float& acs) {
    delta = softplus_f(dtv + dt_bias[h]);
    float x = delta * -fexp(a_log[h]);
#pragma unroll
    for (int o = 1; o < 64; o <<= 1) { const float y = __builtin_bit_cast(float, __builtin_amdgcn_ds_bpermute(4 * (lane - o), __builtin_bit_cast(int, x))); if (lane >= o) x += y; }
    acs = x;
}

template <class Mid> __device__ __forceinline__ void f_ssd_states(Frame& F, const bf16* proj, float* dt, const float* dtp, const float* ssqp, const float* cw, const float* cb, const float* dt_bias, const float* a_log, bf16* ST, float* DEC, unsigned long long& tprev, unsigned long long& tacc, Mid mid) {
#define MSTAMP(id) do { if (TSLOT >= 40 && TSLOT < 50) { const unsigned long long n_ = __builtin_amdgcn_s_memrealtime(); if ((id) == TSLOT) tacc += n_ - tprev; tprev = n_; } } while (0)
    constexpr int LDT = 72;
    LAS bf16* XT = (LAS bf16*)F.lds; LAS bf16* BT = XT + 256 * LDT; LAS float* WG = (LAS float*)(F.lds + 2 * 256 * LDT * 2); LAS float* WL = WG + 512;
    const int lane = fresh_tid() & 63, wave = F.wave;
    {   const int ci = wave >> 2, hh = wave & 3, chunk = F.bid + ci * F.G;
        if (chunk < MG / 64) { const size_t tok = (size_t)chunk * 64 + lane; float dtv;
            if (dtp) { float q = 0.f, d = 0.f;
#pragma unroll
                for (int p4 = 0; p4 < 16; ++p4) q += ssqp[(size_t)p4 * P_STRIDE + tok];
#pragma unroll
                for (int p = 0; p < 16; ++p) d += dtp[((size_t)p * P_STRIDE + tok) * 4 + hh];
                dtv = d * frsq(q * (1.0f / DM) + EPS); dt[tok * 4 + hh] = dtv; }
            else dtv = dt[tok * 4 + hh];
            float delta, acs; ssd_delta_acs(dtv, hh, lane, dt_bias, a_log, delta, acs);
            const float aend = __builtin_bit_cast(float, __builtin_amdgcn_readlane(__builtin_bit_cast(int, acs), 63)); WG[(ci * 4 + hh) * 64 + lane] = delta * fexp(aend - acs);
            if (lane == 63) DEC[chunk * 4 + hh] = fexp(acs); }
    }
    ssd_stage_weights(cw, cb, WL);
    mid();
    int ci = 0;
    for (int chunk = F.bid; chunk < MG / 64; chunk += F.G, ++ci) {
        const int tok0 = chunk * 64, ts0 = tok0 & (SEQ - 1);
        const int tr = lane & 7, cg = (lane >> 3) + 8 * wave, r0 = 8 * tr;
        bf16x8 R[11]; ssd_rows11(proj + (size_t)(tok0 + r0) * NPROJ + 1792 + 8 * cg, ts0 + r0, R);
        MSTAMP(40);
        {   float out[8][8];
            ssd_conv8x8(R, WL + 8 * cg, WL + 3072 + 8 * cg, out);
            if (wave < 4) { const int h = cg >> 3;
#pragma unroll
                for (int i = 0; i < 8; ++i) { const float wg = WG[(ci * 4 + h) * 64 + r0 + i];
#pragma unroll
                    for (int e = 0; e < 8; ++e) out[i][e] *= wg; } }
            LAS bf16* dst = (wave < 4 ? XT : BT) + (8 * (cg & 31)) * LDT + r0;
#pragma unroll
            for (int e = 0; e < 8; ++e) { float o[8];
#pragma unroll
                for (int i = 0; i < 8; ++i) o[i] = out[i][e];
                *(LAS bf16x8*)(dst + e * LDT) = pack8(o); }
        }
        __syncthreads(); MSTAMP(41);
        {   const int h = wave >> 1, nh = wave & 1, g = h >> 1, fr = lane & 15, fq = lane >> 4;
            f32x4 acc[4][4];
#pragma unroll
            for (int a = 0; a < 4; ++a)
#pragma unroll
                for (int b = 0; b < 4; ++b) acc[a][b] = (f32x4){0.f, 0.f, 0.f, 0.f};
#pragma unroll
            for (int ks = 0; ks < 2; ++ks) { bf16x8 xfr[4], nfr[4];
#pragma unroll
                for (int mt = 0; mt < 4; ++mt) xfr[mt] = *(const LAS bf16x8*)(XT + (64 * h + 16 * mt + fr) * LDT + 32 * ks + 8 * fq);
#pragma unroll
                for (int nt = 0; nt < 4; ++nt) nfr[nt] = *(const LAS bf16x8*)(BT + (128 * g + 64 * nh + prow32(nt, fr)) * LDT + 32 * ks + 8 * fq);
#pragma unroll
                for (int mt = 0; mt < 4; ++mt)
#pragma unroll
                    for (int nt = 0; nt < 4; ++nt) acc[mt][nt] = mfma16(nfr[nt], xfr[mt], acc[mt][nt]); }
#pragma unroll
            for (int mt = 0; mt < 4; ++mt)
#pragma unroll
                for (int a = 0; a < 2; ++a) *(GAS bf16x8*)(ST + ((size_t)(chunk * 4 + h) * 64 + 16 * mt + fr) * 128 + 64 * nh + 32 * a + 8 * fq) = pack8v(acc[mt][2 * a], acc[mt][2 * a + 1]);
        }
        __syncthreads(); MSTAMP(42);
    }
}
__device__ __forceinline__ void f_ssd_scan(Frame& F, const bf16* ST, const float* DEC, bf16* PV) {
    const int tid_ = fresh_tid();
    for (int e = F.bid * 512 + tid_; e < (MG / SEQ) * 4 * 64 * 32; e += F.G * 512) { const int n4 = e & 31, p = (e >> 5) & 63, h = (e >> 11) & 3, b = e >> 13;
        const size_t idx0 = ((size_t)((b * (SEQ / 64)) * 4 + h) * 64 + p) * 128 + 4 * n4; constexpr size_t CSTR = (size_t)4 * 64 * 128;
        u32x2 S[SEQ / 64]; float dec[SEQ / 64];
#pragma unroll
        for (int c = 0; c < SEQ / 64; ++c) { S[c] = *(const GAS u32x2*)(ST + idx0 + c * CSTR); dec[c] = DEC[(b * (SEQ / 64) + c) * 4 + h]; }
        float z_ = 0.f; asm volatile("" : "+v"(z_));
        f32x4 c0 = {z_, z_, z_, z_};
#pragma unroll
        for (int c = 0; c < SEQ / 64; ++c) { u32x2 o; o.x = pk2(c0.x, c0.y); o.y = pk2(c0.z, c0.w); *(GAS u32x2*)(PV + idx0 + c * CSTR) = o;
            c0 = c0 * dec[c] + unpack4(S[c]); } }
}
template <class Mid> __device__ __forceinline__ void f_ssd_out(Frame& F, const bf16* proj, const float* dt, const float* cw, const float* cb, const float* dt_bias, const float* a_log, const float* dsk, const float* ng, const bf16* PV, bf16* mix, unsigned long long& tprev, unsigned long long& tacc, Mid mid) {
#define ISTAMP(id) do { if (TSLOT >= 30) { const unsigned long long n_ = __builtin_amdgcn_s_memrealtime(); if ((id) == TSLOT) tacc += n_ - tprev; tprev = n_; } } while (0)
    constexpr int LDN = 264, LDT = 72;
    LAS bf16* CN = (LAS bf16*)F.lds; LAS bf16* BN = CN + 64 * LDN; LAS bf16* XDT = BN + 64 * LDN; LAS bf16* SC = XDT + 256 * LDT;
    LAS float* ACS0 = (LAS float*)(SC + 4 * 64 * LDT); LAS float* DL0 = ACS0 + 512; LAS float* SSQ = DL0 + 512; LAS float* WL = SSQ + 256;
    static_assert(2 * 64 * LDN * 2 + 256 * LDT * 2 + 4 * 64 * LDT * 2 + 5 * 1024 + 3840 * 4 <= LDSCTL_OFF, "ssd_out LDS");
    const int lane = fresh_tid() & 63, wave = F.wave, fr = lane & 15, fq = lane >> 4;
    {   const int ci_ = wave >> 2, hh_ = wave & 3, chunk_ = F.bid + ci_ * F.G;
        if (chunk_ < MG / 64) { float delta, acs; ssd_delta_acs(dt[((size_t)chunk_ * 64 + lane) * 4 + hh_], hh_, lane, dt_bias, a_log, delta, acs); DL0[(ci_ * 4 + hh_) * 64 + lane] = delta; ACS0[(ci_ * 4 + hh_) * 64 + lane] = acs; } }
    ssd_stage_weights(cw, cb, WL);
    int ci = 0;
    for (int chunk = F.bid; chunk < MG / 64; chunk += F.G, ++ci) {
        const LAS float* ACS = ACS0 + ci * 256; const LAS float* DL = DL0 + ci * 256;
        const int tok0 = chunk * 64, ts0 = tok0 & (SEQ - 1);
        const int h3 = wave >> 1, mp = wave & 1, g3 = h3 >> 1;
        const int tr4 = lane & 15, cgl = 4 * wave + fq, r0 = 4 * tr4;
        bf16x8 R[3][7];
#define SSD_LOAD_ROWS(j) _Pragma("unroll") for (int k = 0; k < 7; ++k) R[j][k] = row_or_zero(proj + (size_t)(tok0 + r0 + k - 3) * NPROJ + 1792 + 256 * (j) + 8 * cgl, ts0 + r0 + k - 3);
        SSD_LOAD_ROWS(0) SSD_LOAD_ROWS(1)
        if (ci == 0) mid();
        ISTAMP(30);
        if (!(SSD_SKIP & 1)) {   float out[4][8];
            ssd_conv8x4(R[0], WL + 8 * cgl, WL + 3072 + 8 * cgl, out);
            { const int h = cgl >> 3;
#pragma unroll
              for (int i = 0; i < 4; ++i) { const float dl = DL[h * 64 + r0 + i];
#pragma unroll
                  for (int e = 0; e < 8; ++e) out[i][e] *= dl; }
#pragma unroll
              for (int e = 0; e < 8; ++e) *(LAS u32x2*)(XDT + (8 * cgl + e) * LDT + r0) = pack4((f32x4){out[0][e], out[1][e], out[2][e], out[3][e]}); }
            asm volatile("" ::: "memory"); SSD_LOAD_ROWS(2)
            ssd_conv8x4(R[1], WL + 256 + 8 * cgl, WL + 3072 + 256 + 8 * cgl, out);
#pragma unroll
            for (int i = 0; i < 4; ++i) *(LAS bf16x8*)(BN + (r0 + i) * LDN + 8 * cgl) = pack8(out[i]);
            ssd_conv8x4(R[2], WL + 512 + 8 * cgl, WL + 3072 + 512 + 8 * cgl, out);
#pragma unroll
            for (int i = 0; i < 4; ++i) *(LAS bf16x8*)(CN + (r0 + i) * LDN + 8 * cgl) = pack8(out[i]);
        }
        bf16x8 pfr[4][4];
#pragma unroll
        for (int ks = 0; ks < 4; ++ks)
#pragma unroll
            for (int nt = 0; nt < 4; ++nt) pfr[ks][nt] = *(const GAS bf16x8*)(PV + ((size_t)(chunk * 4 + h3) * 64 + prow32(nt, fr)) * 128 + 32 * ks + 8 * fq);
        v4u zr[2][2];
#pragma unroll
        for (int mi = 0; mi < 2; ++mi)
#pragma unroll
            for (int a = 0; a < 2; ++a) zr[mi][a] = *(const GAS v4u*)((proj + (size_t)(tok0 + 16 * (2 * mp + mi)) * NPROJ + 1536 + 64 * h3 + 32 * a) + fr * NPROJ + 8 * fq);
        __syncthreads(); ISTAMP(31);
        if (!(SSD_SKIP & 2)) {
            const int g = wave >> 2, mt = wave & 3, l = 16 * mt + fr;
#pragma unroll
            for (int nt = 0; nt < 4; ++nt) { f32x4 G = {0.f, 0.f, 0.f, 0.f};
                if (nt <= mt) {
#pragma unroll
                    for (int ks = 0; ks < 4; ++ks) { const bf16x8 cfr = *(const LAS bf16x8*)(CN + (16 * mt + fr) * LDN + 128 * g + 32 * ks + 8 * fq), bfr = *(const LAS bf16x8*)(BN + (16 * nt + fr) * LDN + 128 * g + 32 * ks + 8 * fq);
                        G = mfma16(bfr, cfr, G); } }
                const int s0 = 16 * nt + 4 * fq;
#pragma unroll
                for (int hh = 0; hh < 2; ++hh) { const int h = 2 * g + hh; const float al = ACS[h * 64 + l]; f32x4 v;
                    const float dsk_l = dsk[h] * frcp(fmaxf(DL[h * 64 + l], 1e-30f));
#pragma unroll
                    for (int r = 0; r < 4; ++r) { v[r] = (s0 + r <= l) ? G[r] * fexp(al - ACS[h * 64 + s0 + r]) : 0.f; if (s0 + r == l) v[r] += dsk_l; }
                    *(LAS u32x2*)(SC + (h * 64 + l) * LDT + s0) = pack4(v); } }
        }
#undef SSD_LOAD_ROWS
        __syncthreads(); ISTAMP(32);
        f32x4 y[2][4] = {};
        if (!(SSD_SKIP & 4)) {
#pragma unroll
            for (int mi = 0; mi < 2; ++mi) { const int mt = 2 * mp + mi, l = 16 * mt + fr;
                f32x4 accd[4], acco[4];
#pragma unroll
                for (int nt = 0; nt < 4; ++nt) { accd[nt] = (f32x4){0.f, 0.f, 0.f, 0.f}; acco[nt] = (f32x4){0.f, 0.f, 0.f, 0.f}; }
#pragma unroll
                for (int ks = 0; ks < 2; ++ks) { const bf16x8 sfr = *(const LAS bf16x8*)(SC + (h3 * 64 + 16 * mt + fr) * LDT + 32 * ks + 8 * fq);
#pragma unroll
                    for (int nt = 0; nt < 4; ++nt) { const bf16x8 xfr = *(const LAS bf16x8*)(XDT + (64 * h3 + prow32(nt, fr)) * LDT + 32 * ks + 8 * fq); accd[nt] = mfma16(xfr, sfr, accd[nt]); } }
#pragma unroll
                for (int ks = 0; ks < 4; ++ks) { const bf16x8 cfr = *(const LAS bf16x8*)(CN + (16 * mt + fr) * LDN + 128 * g3 + 32 * ks + 8 * fq);
#pragma unroll
                    for (int nt = 0; nt < 4; ++nt) acco[nt] = mfma16(pfr[ks][nt], cfr, acco[nt]); }
                const float ea = fexp(ACS[h3 * 64 + l]); float q = 0.f;
#pragma unroll
                for (int nt = 0; nt < 4; ++nt) {
                    const v4u zz = zr[mi][nt >> 1]; const f32x4 z = (nt & 1) ? unpack4((u32x2){zz.z, zz.w}) : unpack4((u32x2){zz.x, zz.y});
                    f32x4 v = accd[nt] + ea * acco[nt];
#pragma unroll
                    for (int r = 0; r < 4; ++r) { v[r] *= silu_fast(z[r]); q += v[r] * v[r]; }
                    y[mi][nt] = v; }
                q += lane_xor<16>(q); q = add_xor32(q);
                if (lane < 16) SSQ[h3 * 64 + l] = q; }
        }
        __syncthreads(); ISTAMP(33);
#pragma unroll
        for (int mi = 0; mi < 2; ++mi) { const int l = 16 * (2 * mp + mi) + fr;
            const float rs = frsq((SSQ[(2 * g3) * 64 + l] + SSQ[(2 * g3 + 1) * 64 + l]) * (1.0f / 128.0f) + EPS);
#pragma unroll
            for (int a = 0; a < 2; ++a) { const int pc = 64 * h3 + 32 * a + 8 * fq; const f32x4 gn0 = *(const GAS f32x4*)(ng + pc), gn1 = *(const GAS f32x4*)(ng + pc + 4);
                *(GAS bf16x8*)(mix + (size_t)(tok0 + l) * DM + 768 + pc) = pack8v(y[mi][2 * a] * rs * gn0, y[mi][2 * a + 1] * rs * gn1); } }
        __syncthreads(); ISTAMP(34);
    }
}
#define PHASE_STAGGER(T) do { if ((T) > 0) { const unsigned long long t0_ = __builtin_amdgcn_s_memrealtime(); const unsigned long long d_ = (unsigned long long)(F.bid * (T)); while (__builtin_amdgcn_s_memrealtime() - t0_ < d_) __builtin_amdgcn_s_sleep(1); } } while (0)
#ifndef G4_SYNC
#define G4_SYNC 0
#endif
struct SyncOrder : pg8::StaticOrder {
    unsigned* bar; volatile LAS unsigned* st; unsigned Gb; mutable int nd;
    __device__ __forceinline__ void done(const pg8::Unit&) const { if (nd++ == 0) { XcdBarrier b_; b_.bar = bar; b_.x = xb_xcc_id(); b_.st = st; b_.G = Gb; xcd_barrier(b_); } }
};
__device__ __forceinline__ void p_wdt(Frame& F, const float* w_in, const float* g, bf16* wdt) {
    for (int k = F.gbid * 512 + fresh_tid(); k < DM; k += F.GG * 512) { const f32x4 w = *(const GAS f32x4*)(w_in + (size_t)k * INCOLS + NPROJ) * g[k];
        wdt[k] = (bf16)f2bf(w.x); wdt[DM + k] = (bf16)f2bf(w.y); wdt[2 * DM + k] = (bf16)f2bf(w.z); wdt[3 * DM + k] = (bf16)f2bf(w.w); }
}
template <class Sched, class E_> __device__ __forceinline__ void fill_rstd_issue(Frame& F, const Sched& S, const float* P, E_& E) {
    pg8::Unit u0, ul; if (!S.next(0, u0)) { E.pmA = 0; return; } ul = u0; { const int n = (S.nwg - S.c + S.G - 1) / S.G; if (n > 1) S.next(n - 1, ul); }
    const int tid_ = fresh_tid();
    const int slot = tid_ >> 8, r = tid_ & 255; const size_t row = (size_t)(slot ? ul.pm : u0.pm) * 256 + r;
#pragma unroll
    for (int p4 = 0; p4 < 16; ++p4) E.pv[p4] = P[(size_t)p4 * P_STRIDE + row];
    E.pmA = u0.pm;
}
__global__ void __launch_bounds__(NWAVES * 64, 2) mega_fwd(Args args) {
    extern __shared__ __attribute__((aligned(16))) unsigned char lds[];
    Frame F0;
    F0.lds = (LAS unsigned char*)lds;
    F0.MISC = (volatile LAS unsigned*)(F0.lds + MISC_OFF);
    F0.wave = __builtin_amdgcn_readfirstlane((int)threadIdx.x >> 6);
    F0.GG = gridDim.x; F0.gbid = blockIdx.x; F0.gvcu = (F0.GG % 8 == 0) ? (F0.gbid % 8) * (F0.GG / 8) + F0.gbid / 8 : F0.gbid;
#if GROUP_SPREAD
    constexpr int NXG = 8;
    const int grp0 = (F0.gbid >> 3) % NGROUPS;
    F0.G = F0.GG / NGROUPS; F0.bid = (F0.gbid & 7) + 8 * (F0.gbid / (8 * NGROUPS)); F0.vcu = (F0.bid % NXG) * (F0.G / NXG) + F0.bid / NXG;
#define GRP_OF_BLOCK() ((int)((blockIdx.x >> 3) % NGROUPS))
#else
    constexpr int NXG = 8 / NGROUPS;
    const int grp0 = (F0.gbid & 7) / NXG;
    F0.G = F0.GG / NGROUPS; F0.bid = (F0.gbid & 7) % NXG + NXG * (F0.gbid >> 3); F0.vcu = (F0.bid % NXG) * (F0.G / NXG) + F0.bid / NXG;
#define GRP_OF_BLOCK() ((int)((blockIdx.x & 7) / NXG))
#endif
    unsigned char* ws = args.ws;
    F0.ctl = (gu32*)(ws + WS_CTL);
    for (int u = threadIdx.x; u < (LDS_BYTES - LDSCTL_OFF) / 4; u += NWAVES * 64) ((LAS unsigned*)(F0.lds + LDSCTL_OFF))[u] = 0u;
    __syncthreads();
    (void)xcd_barrier_post((unsigned*)(args.ws + WS_CTL) + CW_BAR, F0.MISC + 8);
    (void)xcd_barrier_post((unsigned*)(args.ws + WS_CTL) + CW_BAR + (1 + grp0) * XCD_BAR_WORDS, F0.MISC + 10);
#define GLOBAL_BAR() do { XcdBarrier b_; b_.bar = (unsigned*)(args.ws + WS_CTL) + CW_BAR; b_.x = xb_xcc_id(); b_.st = (volatile LAS unsigned*)((LAS unsigned char*)lds + MISC_OFF) + 8; b_.G = gridDim.x; xcd_barrier(b_); } while (0)
#define GRID_BAR() do { for (int rb_ = 0; rb_ < REP_BAR; ++rb_) { XcdBarrier b_; b_.bar = (unsigned*)(args.ws + WS_CTL) + CW_BAR + (1 + GRP_OF_BLOCK()) * XCD_BAR_WORDS; b_.x = xb_xcc_id(); b_.st = (volatile LAS unsigned*)((LAS unsigned char*)lds + MISC_OFF) + 10; b_.G = gridDim.x / NGROUPS; xcd_barrier(b_); } } while (0)
#ifndef BPF
#define BPF 1
#endif
#define GRID_BAR_BEGIN() XcdBarrier b_; b_.bar = (unsigned*)(args.ws + WS_CTL) + CW_BAR + (1 + GRP_OF_BLOCK()) * XCD_BAR_WORDS; b_.x = xb_xcc_id(); b_.st = (volatile LAS unsigned*)((LAS unsigned char*)lds + MISC_OFF) + 10; b_.G = gridDim.x / NGROUPS; \
    unsigned xb_old_ = 0u, xb_nloc_ = 1u, xb_nx_ = 1u; xcd_barrier_arrive(b_, xb_old_, xb_nloc_, xb_nx_)
#define GRID_BAR_END() xcd_barrier_finish(b_, xb_old_, xb_nloc_, xb_nx_)
#define GRID_BAR_PFB(LN_, BT_, N_, K_) do { if (BPF) { GRID_BAR_BEGIN(); { const int lq_ = (LN_); { const int l = lq_; PHASE_PTRS pg8::Gemm g{nullptr, BT_, MG, N_, K_, 0}; pg8::StaticOrder S; S.init(MG, N_, F.G, F.bid); pg8::gemm_prefetch_B<true>(F.lds, g, S); } } GRID_BAR_END(); } else { GRID_BAR(); } } while (0)
#if TSLOT >= 0
    unsigned long long t_prev_ = __builtin_amdgcn_s_memrealtime(), t_acc_ = 0ull, c_prev_ = __builtin_amdgcn_s_memtime(), c_acc_ = 0ull, r_acc_ = 1ull;
#define TSTAMP(id) do { const unsigned long long t_now_ = __builtin_amdgcn_s_memrealtime(); const unsigned long long c_now_ = __builtin_amdgcn_s_memtime(); if ((id) == TSLOT) t_acc_ += t_now_ - t_prev_; if ((id) == 9) { c_acc_ += c_now_ - c_prev_; r_acc_ += t_now_ - t_prev_; } t_prev_ = t_now_; c_prev_ = c_now_; } while (0)
#else
#define TSTAMP(id) do {} while (0)
    unsigned long long t_prev_ = 0ull, t_acc_ = 0ull;
#endif
#define in args.in
    constexpr size_t SSQ_STRIDE = (size_t)M * 16;
#define PHASE_PTRS \
    GAS unsigned char* w_ = (GAS unsigned char*)args.ws; int l_ = l, grp_ = grp0; asm volatile("" : "+s"(w_), "+s"(l_), "+s"(grp_));     const int grp = grp_; const size_t r0 = (size_t)grp * MG; \
    Frame Fp = F0; asm volatile("" : "+s"(Fp.bid), "+s"(Fp.G), "+s"(Fp.vcu)); Frame& F = Fp; \
    float* out = args.out + r0 * DM; (void)out; \
    bf16* HB = (bf16*)(w_ + WS_HB) + r0 * DM; unsigned char* actg = (unsigned char*)(w_ + WS_ACT + (size_t)grp * ACT_GROUP_BYTES); \
    bf16* PROJ = (bf16*)actg; bf16* MIX = (bf16*)(actg + (size_t)MG * NPROJ * 2); bf16* HID = (bf16*)actg; (void)HB; (void)PROJ; (void)MIX; (void)HID; \
    float* DT = (float*)(w_ + WS_DT) + r0 * 4; bf16* ST = (bf16*)(w_ + WS_ST) + (r0 / 64) * 4 * 64 * 128; float* DEC = (float*)(w_ + WS_DEC) + (r0 / 64) * 4; bf16* PV = (bf16*)(w_ + WS_PV) + (r0 / 64) * 4 * 64 * 128; (void)DT; (void)ST; (void)DEC; (void)PV; \
    float* SSQ = (float*)(w_ + WS_SSQ) + r0; float* DTP = (float*)(w_ + WS_DTP) + r0 * 4; bf16* WDT = (bf16*)(w_ + WS_WDT); (void)DTP; (void)WDT; \
    bf16* win_t = (bf16*)(w_ + WS_WIN) + (size_t)l_ * NPROJ * DM; bf16* wout_t = (bf16*)(w_ + WS_WOUT) + (size_t)l_ * DM * DM; \
    bf16* wgu_t = (bf16*)(w_ + WS_WGU) + (size_t)l_ * NGU * DM; bf16* wdn_t = (bf16*)(w_ + WS_WDN) + (size_t)l_ * DM * DFF; (void)win_t; (void)wout_t; (void)wgu_t; (void)wdn_t; \
    float* ssq_mix = SSQ + (size_t)(2 * l_) * SSQ_STRIDE; float* ssq_ffn = SSQ + (size_t)(2 * l_ + 1) * SSQ_STRIDE; float* ssq_next = SSQ + (size_t)(2 * l_ + 2) * SSQ_STRIDE; (void)ssq_mix; (void)ssq_ffn; (void)ssq_next;

#pragma unroll 1
    for (int it_ = 0; it_ < DEPTH * REP_P0; ++it_) { const int l = it_ % DEPTH;
        PHASE_PTRS
        p_transpose(F, in[2] + (size_t)l_ * DM * INCOLS, DM, INCOLS, NPROJ / 32, win_t, 0, in[1] + l_ * DM);
        p_transpose(F, in[17] + (size_t)l_ * DM * DM, DM, DM, DM / 32, wout_t, 0, nullptr);
        p_transpose(F, in[19] + (size_t)l_ * DM * DFF, DM, DFF, DFF / 32, wgu_t, 1, in[18] + l_ * DM);
        p_transpose(F, in[20] + (size_t)l_ * DM * DFF, DM, DFF, DFF / 32, wgu_t, 2, in[18] + l_ * DM);
        p_transpose(F, in[21] + (size_t)l_ * DFF * DM, DFF, DM, DM / 32, wdn_t, 0, nullptr);
        p_small_weights(F, in[3] + l_ * 4 * 64 * 64, (bf16*)(w_ + WS_PW) + l_ * 4 * 64 * 64, in[8] + l_ * 4 * 128 * 128, (bf16*)(w_ + WS_SW) + l_ * 4 * 128 * 128);
        p_wdt(F, in[2] + (size_t)l_ * DM * INCOLS, in[1] + l_ * DM, WDT + (size_t)l_ * DM * 4);
    }
#if P0_SHADOW
    { XcdBarrier b_; b_.bar = (unsigned*)(args.ws + WS_CTL) + CW_BAR; b_.x = xb_xcc_id(); b_.st = (volatile LAS unsigned*)((LAS unsigned char*)lds + MISC_OFF) + 8; b_.G = gridDim.x;
      unsigned xb_old_ = 0u, xb_nloc_ = 1u, xb_nx_ = 1u, xb_og_ = 0u; xcd_barrier_arrive_top(b_, xb_old_, xb_nloc_, xb_nx_, xb_og_);
      { const int l = 0; PHASE_PTRS
        p_xpass(F, in[0] + r0 * DM, in[1], in[2] + NPROJ, HB, SSQ, DT); }
      xcd_barrier_finish_top(b_, xb_old_, xb_nloc_, xb_nx_, xb_og_); }
    GRID_BAR_PFB(0, win_t, NPROJ, DM); TSTAMP(0);
#else
    { const int l = 0; PHASE_PTRS
      for (int rep_ = 0; rep_ < REP_XPASS; ++rep_) p_xpass(F, in[0] + r0 * DM, in[1], in[2] + NPROJ, HB, SSQ, DT); }
    GLOBAL_BAR(); TSTAMP(0);
#endif
    if (SKEW_US > 0 && grp0 > 0) { const unsigned long long t0_ = __builtin_amdgcn_s_memrealtime(); while (__builtin_amdgcn_s_memrealtime() - t0_ < (unsigned long long)(grp0 * SKEW_US * 100)) __builtin_amdgcn_s_sleep(8); }
#pragma clang loop unroll(full)
    for (int l = 0; l < DEPTH; ++l) {
        { PHASE_PTRS
          pg8::Gemm g{HB, win_t, MG, NPROJ, DM, 0}; pg8::StaticOrder S; S.init(MG, NPROJ, F.G, F.bid); pg8::EpiProj E{PROJ, (const LAS float*)(F.lds + RT_OFF), 0, NPROJ}; fill_rstd_issue(F, S, ssq_mix, E);
          PHASE_STAGGER(STAG_G1);
          if (BPF && (l > 0 || P0_SHADOW)) pg8::gemm_phase<pg8::EpiProj, pg8::StaticOrder, GEMM_ALIGN, GEMM_SP2, true>(F.lds, g, S, E);
          else for (int rep_ = 0; rep_ < REP_G1; ++rep_) pg8::gemm_phase<pg8::EpiProj, pg8::StaticOrder, GEMM_ALIGN, GEMM_SP2>(F.lds, g, S, E); }
#if BPF
        { GRID_BAR_BEGIN();
          PHASE_PTRS
          f_ssd_states(F, PROJ, DT, l_ > 0 ? DTP : nullptr, ssq_mix, in[11] + l_ * 4 * 768, in[12] + l_ * 768, in[13] + l_ * 4, in[14] + l_ * 4, ST, DEC, t_prev_, t_acc_, [&]() { GRID_BAR_END(); }); }
#else
        TSTAMP(24); GRID_BAR(); TSTAMP(1);
        { PHASE_PTRS
          for (int rep_ = 0; rep_ < REP_M1; ++rep_) f_ssd_states(F, PROJ, DT, l_ > 0 ? DTP : nullptr, ssq_mix, in[11] + l_ * 4 * 768, in[12] + l_ * 768, in[13] + l_ * 4, in[14] + l_ * 4, ST, DEC, t_prev_, t_acc_, []() {}); }
#endif
#if BPF && MIX_SHADOW == 2
        { GRID_BAR_BEGIN();
          { PHASE_PTRS
            f_pool(F, PROJ, (const bf16*)(w_ + WS_PW) + l_ * 4 * 64 * 64, in[4] + l_ * 256, in[5] + l_ * 256, MIX); }
          { PHASE_PTRS
            f_sgu(F, PROJ, in[6] + l_ * 256, in[7] + l_ * 256, (const bf16*)(w_ + WS_SW) + l_ * 4 * 128 * 128, in[9] + l_ * 4 * 128, MIX); }
          { PHASE_PTRS
            f_sconv(F, PROJ, in[10] + l_ * 3 * 256, MIX); }
          GRID_BAR_END(); }
        { PHASE_PTRS
          f_ssd_scan(F, ST, DEC, PV); }
        { GRID_BAR_BEGIN();
          PHASE_PTRS
          f_ssd_out(F, PROJ, DT, in[11] + l_ * 4 * 768, in[12] + l_ * 768, in[13] + l_ * 4, in[14] + l_ * 4, in[15] + l_ * 4, in[16] + l_ * 256, PV, MIX, t_prev_, t_acc_, [&]() { GRID_BAR_END(); }); }
#elif BPF && MIX_SHADOW == 1
        { GRID_BAR_BEGIN();
          { PHASE_PTRS
            f_pool(F, PROJ, (const bf16*)(w_ + WS_PW) + l_ * 4 * 64 * 64, in[4] + l_ * 256, in[5] + l_ * 256, MIX); }
          GRID_BAR_END(); }
        { PHASE_PTRS
          f_ssd_scan(F, ST, DEC, PV); }
        { GRID_BAR_BEGIN();
          { PHASE_PTRS
            f_sgu(F, PROJ, in[6] + l_ * 256, in[7] + l_ * 256, (const bf16*)(w_ + WS_SW) + l_ * 4 * 128 * 128, in[9] + l_ * 4 * 128, MIX); }
          { PHASE_PTRS
            f_sconv(F, PROJ, in[10] + l_ * 3 * 256, MIX); }
          PHASE_PTRS
          f_ssd_out(F, PROJ, DT, in[11] + l_ * 4 * 768, in[12] + l_ * 768, in[13] + l_ * 4, in[14] + l_ * 4, in[15] + l_ * 4, in[16] + l_ * 256, PV, MIX, t_prev_, t_acc_, [&]() { GRID_BAR_END(); }); }
#else
        TSTAMP(20);
        { PHASE_PTRS
          for (int rep_ = 0; rep_ < REP_POOL; ++rep_) f_pool(F, PROJ, (const bf16*)(w_ + WS_PW) + l_ * 4 * 64 * 64, in[4] + l_ * 256, in[5] + l_ * 256, MIX); }
        TSTAMP(21);
        { PHASE_PTRS
          for (int rep_ = 0; rep_ < REP_SGU; ++rep_) f_sgu(F, PROJ, in[6] + l_ * 256, in[7] + l_ * 256, (const bf16*)(w_ + WS_SW) + l_ * 4 * 128 * 128, in[9] + l_ * 4 * 128, MIX); }
        TSTAMP(22);
        { PHASE_PTRS
          for (int rep_ = 0; rep_ < REP_SCONV; ++rep_) f_sconv(F, PROJ, in[10] + l_ * 3 * 256, MIX); }
        TSTAMP(23);
        GRID_BAR(); TSTAMP(2);
        { PHASE_PTRS
          for (int rep_ = 0; rep_ < REP_SCAN; ++rep_) f_ssd_scan(F, ST, DEC, PV); }
#if BPF
        { GRID_BAR_BEGIN();
          PHASE_PTRS
          f_ssd_out(F, PROJ, DT, in[11] + l_ * 4 * 768, in[12] + l_ * 768, in[13] + l_ * 4, in[14] + l_ * 4, in[15] + l_ * 4, in[16] + l_ * 256, PV, MIX, t_prev_, t_acc_, [&]() { GRID_BAR_END(); }); }
#else
        GRID_BAR(); TSTAMP(3);
        { PHASE_PTRS
          for (int rep_ = 0; rep_ < REP_SSDOUT; ++rep_) f_ssd_out(F, PROJ, DT, in[11] + l_ * 4 * 768, in[12] + l_ * 768, in[13] + l_ * 4, in[14] + l_ * 4, in[15] + l_ * 4, in[16] + l_ * 256, PV, MIX, t_prev_, t_acc_, []() {}); }
#endif
#endif
        GRID_BAR_PFB(l, wout_t, DM, DM); TSTAMP(4);
        { PHASE_PTRS
          pg8::Gemm g{MIX, wout_t, MG, DM, DM, 0}; pg8::StaticOrder S; S.init(MG, DM, F.G, F.bid);
          { pg8::EpiRes<false, false, false> E{HB, HB, ssq_ffn, nullptr, nullptr, DM, 0}; pg8::gemm_phase<pg8::EpiRes<false, false, false>, pg8::StaticOrder, GEMM_ALIGN, GEMM_SP2, BPF != 0>(F.lds, g, S, E); } }
#if PROBE_G2
        { PHASE_PTRS
          pg8::Gemm g{MIX, wout_t, MG, DM, DM, 0}; pg8::StaticOrder S; S.init(MG, DM, F.G, F.bid);
          pg8::EpiRes<false, false, false> E{HB, (bf16*)ST, (float*)PV, nullptr, nullptr, DM, PROBE_NOP}; pg8::gemm_phase<pg8::EpiRes<false, false, false>, pg8::StaticOrder, GEMM_ALIGN, GEMM_SP2>(F.lds, g, S, E); }
#endif
        TSTAMP(25); GRID_BAR_PFB(l, wgu_t, NGU, DM); TSTAMP(5);
        { PHASE_PTRS
          pg8::Gemm g{HB, wgu_t, MG, NGU, DM, 0}; pg8::StaticOrder S; S.init(MG, NGU, F.G, F.bid); pg8::EpiSwiGLU E{HID, (const LAS float*)(F.lds + RT_OFF), 0, DFF}; fill_rstd_issue(F, S, ssq_ffn, E);
          PHASE_STAGGER(STAG_G3);
          for (int rep_ = 0; rep_ < REP_G3; ++rep_) pg8::gemm_phase<pg8::EpiSwiGLU, pg8::StaticOrder, GEMM_ALIGN, GEMM_SP2, BPF != 0>(F.lds, g, S, E); }
        TSTAMP(26); GRID_BAR_PFB(l, wdn_t, DM, DFF); TSTAMP(6);
        { PHASE_PTRS
#if G4_SYNC
          typedef SyncOrder G4Order;
          pg8::Gemm g{HID, wdn_t, MG, DM, DFF, 0}; G4Order S; S.init(MG, DM, F.G, F.bid); S.bar = (unsigned*)(w_ + WS_CTL) + CW_BAR + (1 + grp_) * XCD_BAR_WORDS; S.st = (volatile LAS unsigned*)((LAS unsigned char*)F.lds + MISC_OFF) + 10; S.Gb = gridDim.x / NGROUPS; S.nd = 0;
#else
          typedef pg8::StaticOrder G4Order;
          pg8::Gemm g{HID, wdn_t, MG, DM, DFF, 0}; G4Order S; S.init(MG, DM, F.G, F.bid);
#endif
          if (l_ + 1 < DEPTH) { pg8::EpiRes<false, false, true> E{HB, HB, ssq_next, WDT + (size_t)(l_ + 1) * DM * 4, DTP, DM, 0}; pg8::gemm_phase<pg8::EpiRes<false, false, true>, G4Order, GEMM_ALIGN, GEMM_SP2, BPF != 0>(F.lds, g, S, E); }
#if FUSE_FINAL
          else { pg8::EpiResFinal E{HB, out, (unsigned*)ssq_next, (unsigned*)(w_ + WS_CTL) + CW_FIN, in[22], (unsigned*)(w_ + WS_CTL) + 8, DM, (int)(r0 / 256)}; pg8::gemm_phase<pg8::EpiResFinal, G4Order, GEMM_ALIGN, GEMM_SP2, BPF != 0>(F.lds, g, S, E); } }
#else
          else { pg8::EpiRes<false, false, false> E{HB, HB, ssq_next, nullptr, nullptr, DM, 0}; pg8::gemm_phase<pg8::EpiRes<false, false, false>, pg8::StaticOrder, GEMM_ALIGN, GEMM_SP2>(F.lds, g, S, E); } }
#endif
#if PROBE_G4
        { PHASE_PTRS
          pg8::Gemm g{HID, wdn_t, MG, DM, DFF, 0}; pg8::StaticOrder S; S.init(MG, DM, F.G, F.bid);
          pg8::EpiRes<false, false, false> E{HB, (bf16*)ST, (float*)PV, nullptr, nullptr, DM, PROBE_NOP}; pg8::gemm_phase<pg8::EpiRes<false, false, false>, pg8::StaticOrder, GEMM_ALIGN, GEMM_SP2>(F.lds, g, S, E); }
#endif
        TSTAMP(27); if (l + 1 < DEPTH) { GRID_BAR_PFB(l + 1, win_t, NPROJ, DM); } else if (!FUSE_FINAL) { GRID_BAR(); } TSTAMP(7);
    }
#if PROBE_KLOOP == 1
    { const int l = 0; PHASE_PTRS
      pg8::Gemm g{HB, wgu_t, MG, NGU, DM, 0}; pg8::FixedOrder S{11}; pg8::EpiNull E;
      pg8::gemm_phase<pg8::EpiNull, pg8::FixedOrder, true, true>(F.lds, g, S, E); }
    GRID_BAR(); TSTAMP(9);
#elif PROBE_KLOOP == 2
    { const int l = 0; PHASE_PTRS
      pg8::Gemm g{HB, wgu_t, MG, NGU, DM, 0}; pg8::StaticOrder S; S.init(MG, NGU, F.G, F.bid); pg8::EpiNull E;
      pg8::gemm_phase<pg8::EpiNull, pg8::StaticOrder, GEMM_ALIGN, GEMM_SP2>(F.lds, g, S, E); }
    GRID_BAR(); TSTAMP(9);
#elif PROBE_KLOOP == 3
    { const int l = 0; PHASE_PTRS
      pg8::Gemm g{HID, wdn_t, MG, DM, DFF, 0}; pg8::StaticOrder S; S.init(MG, DM, F.G, F.bid); pg8::EpiNull E;
      pg8::gemm_phase<pg8::EpiNull, pg8::StaticOrder, GEMM_ALIGN, GEMM_SP2>(F.lds, g, S, E); }
    GRID_BAR(); TSTAMP(9);
#elif PROBE_KLOOP == 4
    { const int l = 0; PHASE_PTRS
      pg8::Gemm g{HID, wdn_t, MG, DM, DFF, 0}; pg8::FixedOrder S{2}; pg8::EpiNull E;
      pg8::gemm_phase<pg8::EpiNull, pg8::FixedOrder, true, true>(F.lds, g, S, E); }
    GRID_BAR(); TSTAMP(9);
#elif PROBE_KLOOP == 8
    { const int l = 0; PHASE_PTRS
      pg8::Gemm g{HB, wgu_t, MG, PROBE_N, DM, 0}; pg8::StaticOrder S; S.init(MG, PROBE_N, F.G, F.bid); pg8::EpiNull E;
      pg8::gemm_phase<pg8::EpiNull, pg8::StaticOrder, GEMM_ALIGN, GEMM_SP2>(F.lds, g, S, E); }
    GRID_BAR(); TSTAMP(9);
#elif PROBE_KLOOP == 9
    { const int l = 0; PHASE_PTRS
      pg8::Gemm g{HB, win_t, MG, PROBE_N, DM, 0}; pg8::StaticOrder S; S.init(MG, PROBE_N, F.G, F.bid); pg8::EpiNull E;
      pg8::gemm_phase<pg8::EpiNull, pg8::StaticOrder, GEMM_ALIGN, GEMM_SP2>(F.lds, g, S, E); }
    GRID_BAR(); TSTAMP(9);
#elif PROBE_KLOOP == 5
    { const int l = 0; PHASE_PTRS
      pg8::Gemm g{HB, win_t, MG, NPROJ, DM, 0}; pg8::StaticOrder S; S.init(MG, NPROJ, F.G, F.bid); pg8::EpiNull E;
      pg8::gemm_phase<pg8::EpiNull, pg8::StaticOrder, GEMM_ALIGN, GEMM_SP2>(F.lds, g, S, E); }
    GRID_BAR(); TSTAMP(9);
#elif PROBE_KLOOP == 6 || PROBE_KLOOP == 7
    { const int l = 0; PHASE_PTRS
      pg8::Gemm g{HB, win_t, MG, NPROJ, DM, 0}; pg8::StaticOrder S; S.init(MG, NPROJ, F.G, F.bid); pg8::EpiProjT<PROBE_KLOOP == 6> E{PROJ, (const LAS float*)(F.lds + RT_OFF), 0, NPROJ}; fill_rstd_issue(F, S, ssq_mix, E);
      pg8::gemm_phase<pg8::EpiProjT<PROBE_KLOOP == 6>, pg8::StaticOrder, GEMM_ALIGN, GEMM_SP2>(F.lds, g, S, E); }
    GRID_BAR(); TSTAMP(9);
#endif
#if !FUSE_FINAL
    { const int l = DEPTH; PHASE_PTRS
      p_finalnorm(F, HB, out, SSQ + (size_t)(2 * DEPTH) * SSQ_STRIDE, in[22]); }
#endif
#if TSLOT >= 0
    TSTAMP(10);
    if (blockIdx.x == TBLK && threadIdx.x == 0) { asm volatile("s_waitcnt vmcnt(0)" ::: "memory"); args.out[0] = TSLOT == 99 ? (float)(((c_acc_ * 100ull / r_acc_) / CQ) * CQ) : TSLOT == 98 ? (float)(((c_acc_ / 176ull) / CQ) * CQ) : TQUANT > 0 ? (float)((t_acc_ / (100ull * TQUANT)) * TQUANT) : (float)t_acc_ * 0.01f; }
#endif
#undef in
}

extern "C" void kernel_launch(void* const* d_in, const int* in_sizes, int n_in, void* d_out, int out_size, void* d_ws, size_t ws_size, hipStream_t stream) {
    static int grid = 0;
    if (grid == 0) {
        if (n_in != 23 || out_size != M * DM || ws_size < WS_END) { fprintf(stderr, "kernel_launch: unexpected shapes (n_in %d out %d ws %zu)\n", n_in, out_size, ws_size); grid = -1; return; }
        int dev = 0, cus = 0, per_cu = 0;
        if (hipGetDevice(&dev) != hipSuccess || hipDeviceGetAttribute(&cus, hipDeviceAttributeMultiprocessorCount, dev) != hipSuccess) { grid = -1; return; }
        if (hipFuncSetAttribute((const void*)mega_fwd, hipFuncAttributeMaxDynamicSharedMemorySize, LDS_BYTES) != hipSuccess) { fprintf(stderr, "kernel_launch: hipFuncSetAttribute failed\n"); grid = -1; return; }
        if (hipOccupancyMaxActiveBlocksPerMultiprocessor(&per_cu, (const void*)mega_fwd, NWAVES * 64, LDS_BYTES) != hipSuccess || per_cu < 1) { fprintf(stderr, "kernel_launch: occupancy query says %d blocks per CU\n", per_cu); (void)hipGetLastError(); grid = -1; return; }
        grid = cus;
        if (grid != 256) { fprintf(stderr, "kernel_launch: built for a 256-CU device (one workgroup per CU, 8 batch groups of 32); this device reports %d CUs; nothing launched\n", cus); grid = -1; return; }
        if (MG / 64 > 2 * (grid / NGROUPS)) { fprintf(stderr, "kernel_launch: more than two SSD chunks per workgroup; nothing launched\n"); grid = -1; return; }
        { const int Ns[3] = {NPROJ, DM, NGU}; bool ok = true;
          for (int t = 0; t < 3 && ok; ++t) for (int c = 0; c < grid / NGROUPS && ok; ++c) { pg8::StaticOrder S; S.init(MG, Ns[t], grid / NGROUPS, c); pg8::Unit u, u0, ul; if (!S.next(0, u0)) continue; ul = u0; for (int i = 1; S.next(i, u); ++i) ul = u;
              for (int i = 0; S.next(i, u); ++i) if (u.pm != u0.pm && u.pm != ul.pm) ok = false; }
          if (!ok) { fprintf(stderr, "kernel_launch: the unit order gives a workgroup more than two row panels; nothing launched\n"); grid = -1; return; } }
    }
    if (grid < 0) return;
    if (hipMemsetAsync((char*)d_ws + WS_CTL, 0, CTL_ZERO_BYTES, stream) != hipSuccess) { fprintf(stderr, "kernel_launch: memset failed\n"); return; }
    Args a{};
    for (int i = 0; i < 23; ++i) a.in[i] = (const float*)d_in[i];
    a.out = (float*)d_out; a.ws = (unsigned char*)d_ws;
    hipLaunchKernelGGL(mega_fwd, dim3(grid), dim3(NWAVES * 64), LDS_BYTES, stream, a);
}
```
